# Optimizing an MI355X kernel written in HIP

```python
import jax, jax.numpy as jnp
from jax import lax
import numpy as np

D_MODEL = 1024
BATCH = 2
SEQ = 8192
DEPTH = 2

HEAD_DIM = 64
ROPE_THETA = 10000.0
EPS = 1e-6
Q_BLOCK = 128

A_HEADS = 4
MOBA_BLOCK = 256
MOBA_TOPK = 3
B_HEADS = 8
B_KV_HEADS = 2
WINDOW = 128
C_HEADS = 4
C_HALF = HEAD_DIM // 2

N_BRANCH = 3
D_FF = 2816
CONV_W = 3

A_W = A_HEADS * HEAD_DIM
B_QW = B_HEADS * HEAD_DIM
B_KVW = B_KV_HEADS * HEAD_DIM
C_W = C_HEADS * HEAD_DIM
IN_SIZES = (A_W, A_W, A_W, B_QW, B_KVW, B_KVW, C_W, C_W, C_W, N_BRANCH * D_MODEL)
IN_COLS = sum(IN_SIZES)
SPLIT_POINTS = tuple(np.cumsum(IN_SIZES)[:-1].tolist())

kernel_name = "hybrid_moba_swa_diff_convglu"


def rms_norm(x, g):
    x32 = x.astype(jnp.float32)
    y = x32 * lax.rsqrt(jnp.mean(x32 * x32, axis=-1, keepdims=True) + EPS)
    return (y * g.astype(jnp.float32)).astype(x.dtype)


def rope_tables(seq, dim):
    inv = 1.0 / (ROPE_THETA ** (jnp.arange(0, dim, 2, dtype=jnp.float32) / dim))
    ang = jnp.arange(seq, dtype=jnp.float32)[:, None] * inv[None, :]
    return jnp.cos(ang), jnp.sin(ang)


def apply_rope(x, cos, sin):
    half = x.shape[-1] // 2
    shape = (1, x.shape[1]) + (1,) * (x.ndim - 3) + (half,)
    c = cos.reshape(shape).astype(x.dtype)
    s = sin.reshape(shape).astype(x.dtype)
    x1, x2 = x[..., :half], x[..., half:]
    return jnp.concatenate([x1 * c - x2 * s, x2 * c + x1 * s], axis=-1)


def moba_attention(q, k, v):
    B, S, H, d = q.shape
    n_blk = -(-S // MOBA_BLOCK)
    pad = n_blk * MOBA_BLOCK - S
    padw = ((0, 0), (0, pad), (0, 0), (0, 0))
    kb = jnp.pad(k, padw).reshape(B, n_blk, MOBA_BLOCK, H, d).transpose(0, 3, 1, 2, 4)
    vb = jnp.pad(v, padw).reshape(B, n_blk, MOBA_BLOCK, H, d).transpose(0, 3, 1, 2, 4)
    k_mean = kb.mean(axis=3)
    topk = min(MOBA_TOPK, n_blk)
    n_chunks = S // Q_BLOCK
    qc = q.reshape(B, n_chunks, Q_BLOCK, H, d).transpose(1, 0, 3, 2, 4)
    b_idx = jnp.arange(B)[:, None, None, None]
    h_idx = jnp.arange(H)[None, :, None, None]
    scale = d ** -0.5
    n_sel = topk * MOBA_BLOCK

    def one_chunk(args):
        c, qh = args
        q_pos = c * Q_BLOCK + jnp.arange(Q_BLOCK)
        own = (c * Q_BLOCK) // MOBA_BLOCK
        gate = jnp.einsum('bhqd,bhnd->bhqn', qh, k_mean).astype(jnp.float32)
        gate = jnp.where(jnp.arange(n_blk) < own, gate, -jnp.inf)
        _, idx = lax.top_k(gate, topk)
        valid = jnp.arange(topk) < own
        k_sel = kb[b_idx, h_idx, idx]
        v_sel = vb[b_idx, h_idx, idx]
        s_sel = jnp.einsum('bhqd,bhqjld->bhqjl', qh, k_sel).astype(jnp.float32) * scale
        s_sel = jnp.where(valid[:, None], s_sel, -jnp.inf).reshape(B, H, Q_BLOCK, n_sel)
        k_own = lax.dynamic_index_in_dim(kb, own, axis=2, keepdims=False)
        v_own = lax.dynamic_index_in_dim(vb, own, axis=2, keepdims=False)
        s_own = jnp.einsum('bhqd,bhld->bhql', qh, k_own).astype(jnp.float32) * scale
        k_pos = own * MOBA_BLOCK + jnp.arange(MOBA_BLOCK)
        s_own = jnp.where(k_pos[None, :] <= q_pos[:, None], s_own, -jnp.inf)
        p = jax.nn.softmax(jnp.concatenate([s_sel, s_own], axis=-1), axis=-1).astype(v.dtype)
        p_sel = p[..., :n_sel].reshape(B, H, Q_BLOCK, topk, MOBA_BLOCK)
        p_own = p[..., n_sel:]
        return (jnp.einsum('bhqjl,bhqjld->bhqd', p_sel, v_sel)
                + jnp.einsum('bhql,bhld->bhqd', p_own, v_own))

    o = lax.map(one_chunk, (jnp.arange(n_chunks), qc))
    return o.transpose(1, 0, 3, 2, 4).reshape(B, S, H * d)


def sliding_window_sink_attention(q, k, v, sinks):
    B, S, Hq, d = q.shape
    Hkv = k.shape[2]
    G = Hq // Hkv
    nb = S // WINDOW
    qb = q.reshape(B, nb, WINDOW, Hkv, G, d)

    def band(t):
        tb = t.reshape(B, nb, WINDOW, Hkv, d)
        prev = jnp.concatenate([jnp.zeros_like(tb[:, :1]), tb[:, :-1]], axis=1)
        return jnp.concatenate([prev, tb], axis=2)

    kband, vband = band(k), band(v)
    s = jnp.einsum('bnqkgd,bnjkd->bnkgqj', qb, kband).astype(jnp.float32) * (d ** -0.5)
    rel = jnp.arange(WINDOW)[:, None] + WINDOW - jnp.arange(2 * WINDOW)[None, :]
    in_win = (rel >= 0) & (rel < WINDOW)
    k_abs = jnp.arange(nb)[:, None] * WINDOW - WINDOW + jnp.arange(2 * WINDOW)[None, :]
    mask = in_win[None, :, :] & (k_abs >= 0)[:, None, :]
    s = jnp.where(mask[None, :, None, None], s, -jnp.inf)
    sink = sinks.astype(jnp.float32).reshape(1, 1, Hkv, G, 1, 1)
    m = jnp.maximum(s.max(axis=-1, keepdims=True), sink)
    p = jnp.exp(s - m)
    denom = p.sum(axis=-1, keepdims=True) + jnp.exp(sink - m)
    o = jnp.einsum('bnkgqj,bnjkd->bnqkgd', (p / denom).astype(v.dtype), vband)
    return o.reshape(B, S, Hq * d)


def differential_attention(q, k, v, lam, subln_g, lam_init):
    B, S, H, _, dh = q.shape
    n_chunks = S // Q_BLOCK
    qc = q.reshape(B, n_chunks, Q_BLOCK, H, 2, dh).transpose(1, 0, 2, 3, 4, 5)
    scale = dh ** -0.5
    k_pos = jnp.arange(S)

    def one_chunk(args):
        c, qq = args
        q_pos = c * Q_BLOCK + jnp.arange(Q_BLOCK)
        s = jnp.einsum('bqhcd,bkhcd->bhcqk', qq, k).astype(jnp.float32) * scale
        s = jnp.where(k_pos[None, :] <= q_pos[:, None], s, -jnp.inf)
        p = jax.nn.softmax(s, axis=-1)
        a = (p[:, :, 0] - lam * p[:, :, 1]).astype(v.dtype)
        return jnp.einsum('bhqk,bkhd->bqhd', a, v)

    o = lax.map(one_chunk, (jnp.arange(n_chunks), qc))
    o = o.transpose(1, 0, 2, 3, 4).reshape(B, S, H, 2 * dh)
    o = rms_norm(o, subln_g) * (1.0 - lam_init)
    return o.reshape(B, S, H * 2 * dh)


def causal_depthwise_conv(u, w, b):
    S = u.shape[1]
    up = jnp.pad(u, ((0, 0), (CONV_W - 1, 0), (0, 0)))
    y = b.astype(u.dtype)
    for j in range(CONV_W):
        y = y + up[:, j:j + S] * w[j]
    return y


def setup_inputs(seed: int = 0) -> dict:
    key = jax.random.key(seed)
    ks = jax.random.split(key, 24)
    n = jax.random.normal
    f32 = jnp.float32

    def gain(k, shape):
        return 1.0 + 0.02 * n(k, shape, f32)

    return {
        "x": n(ks[0], (BATCH, SEQ, D_MODEL), f32),
        "attn_norm": gain(ks[1], (DEPTH, D_MODEL)),
        "w_in": n(ks[2], (DEPTH, D_MODEL, IN_COLS), f32) * D_MODEL ** -0.5,
        "qn_a": gain(ks[3], (DEPTH, HEAD_DIM)),
        "kn_a": gain(ks[4], (DEPTH, HEAD_DIM)),
        "qn_b": gain(ks[5], (DEPTH, HEAD_DIM)),
        "kn_b": gain(ks[6], (DEPTH, HEAD_DIM)),
        "sinks": 0.5 * n(ks[7], (DEPTH, B_HEADS), f32),
        "qn_c": gain(ks[8], (DEPTH, C_HALF)),
        "kn_c": gain(ks[9], (DEPTH, C_HALF)),
        "lam_q1": 0.1 * n(ks[10], (DEPTH, C_HALF), f32),
        "lam_k1": 0.1 * n(ks[11], (DEPTH, C_HALF), f32),
        "lam_q2": 0.1 * n(ks[12], (DEPTH, C_HALF), f32),
        "lam_k2": 0.1 * n(ks[13], (DEPTH, C_HALF), f32),
        "subln": gain(ks[14], (DEPTH, HEAD_DIM)),
        "w_pa": n(ks[15], (DEPTH, A_W, D_MODEL), f32) * A_W ** -0.5,
        "w_pb": n(ks[16], (DEPTH, B_QW, D_MODEL), f32) * B_QW ** -0.5,
        "w_pc": n(ks[17], (DEPTH, C_W, D_MODEL), f32) * C_W ** -0.5,
        "w_out": n(ks[18], (DEPTH, D_MODEL, D_MODEL), f32) * D_MODEL ** -0.5,
        "mlp_norm": gain(ks[19], (DEPTH, D_MODEL)),
        "w_up": n(ks[20], (DEPTH, D_MODEL, 2 * D_FF), f32) * D_MODEL ** -0.5,
        "conv_w": 0.5 * n(ks[21], (DEPTH, CONV_W, 2 * D_FF), f32),
        "conv_b": 0.01 * n(ks[22], (DEPTH, 2 * D_FF), f32),
        "w_down": n(ks[23], (DEPTH, D_FF, D_MODEL), f32) * D_FF ** -0.5,
    }


def reference(x, attn_norm, w_in, qn_a, kn_a, qn_b, kn_b, sinks, qn_c, kn_c,
              lam_q1, lam_k1, lam_q2, lam_k2, subln, w_pa, w_pb, w_pc, w_out,
              mlp_norm, w_up, conv_w, conv_b, w_down):
    B, S, D = x.shape
    cos64, sin64 = rope_tables(S, HEAD_DIM)
    cos32, sin32 = rope_tables(S, C_HALF)
    for i in range(DEPTH):
        lam_init = 0.8 - 0.6 * float(np.exp(-0.3 * i))
        h = rms_norm(x, attn_norm[i])
        proj = h @ w_in[i]
        qa, ka, va, qb, kb, vb, qc, kc, vc, gates = jnp.split(proj, SPLIT_POINTS, axis=-1)

        qa = apply_rope(rms_norm(qa.reshape(B, S, A_HEADS, HEAD_DIM), qn_a[i]), cos64, sin64)
        ka = apply_rope(rms_norm(ka.reshape(B, S, A_HEADS, HEAD_DIM), kn_a[i]), cos64, sin64)
        ya = moba_attention(qa, ka, va.reshape(B, S, A_HEADS, HEAD_DIM))

        qb = apply_rope(rms_norm(qb.reshape(B, S, B_HEADS, HEAD_DIM), qn_b[i]), cos64, sin64)
        kb = apply_rope(rms_norm(kb.reshape(B, S, B_KV_HEADS, HEAD_DIM), kn_b[i]), cos64, sin64)
        yb = sliding_window_sink_attention(qb, kb, vb.reshape(B, S, B_KV_HEADS, HEAD_DIM), sinks[i])

        qc = apply_rope(rms_norm(qc.reshape(B, S, C_HEADS, 2, C_HALF), qn_c[i]), cos32, sin32)
        kc = apply_rope(rms_norm(kc.reshape(B, S, C_HEADS, 2, C_HALF), kn_c[i]), cos32, sin32)
        lam = (jnp.exp(jnp.sum(lam_q1[i].astype(jnp.float32) * lam_k1[i].astype(jnp.float32)))
               - jnp.exp(jnp.sum(lam_q2[i].astype(jnp.float32) * lam_k2[i].astype(jnp.float32)))
               + lam_init)
        yc = differential_attention(qc, kc, vc.reshape(B, S, C_HEADS, HEAD_DIM), lam, subln[i], lam_init)

        g = jax.nn.sigmoid(gates.reshape(B, S, N_BRANCH, D))
        merged = g[:, :, 0] * (ya @ w_pa[i]) + g[:, :, 1] * (yb @ w_pb[i]) + g[:, :, 2] * (yc @ w_pc[i])
        x = x + merged @ w_out[i]

        h = rms_norm(x, mlp_norm[i])
        u = causal_depthwise_conv(h @ w_up[i], conv_w[i], conv_b[i])
        gate_u, val_u = jnp.split(u, 2, axis=-1)
        x = x + (jax.nn.silu(gate_u) * val_u) @ w_down[i]
    return x
```

```cpp
#include <hip/hip_runtime.h>
#include <hip/hip_cooperative_groups.h>
#include <cstdio>
#include <cstdint>
#include <cmath>
namespace cg = cooperative_groups;

namespace pg8 {
#define PG8_LAS __attribute__((address_space(3)))
typedef unsigned short bf16_t;
typedef short bf16x8 __attribute__((ext_vector_type(8)));
typedef float f32x4 __attribute__((ext_vector_type(4)));
typedef unsigned u32x4 __attribute__((ext_vector_type(4)));
constexpr int BM = 256, BK = 64, HALF = 128, HTB = HALF * BK * 2  , STAGE_BYTES = 8 * HTB, NXCD = 8, WGM = 8;

__host__ __device__ __forceinline__ int lds_byte(int r, int c) { const int st = (r >> 4) * 2 + (c >> 5), rr = r & 15, cc = c & 31, ob = rr * 64 + cc * 2; return st * 1024 + (ob ^ (((ob >> 9) & 1) << 5)); }
__host__ __device__ __forceinline__ void stage_rc(int b, int& R, int& C) { const int st = b / 1024, sb = b % 1024, swz = sb ^ (((sb >> 9) & 1) << 5); R = (st >> 1) * 16 + swz / 64; C = (st & 1) * 32 + (swz % 64) / 2; }
__host__ __device__ __forceinline__ int perm32(int rho) { const int n = rho >> 4, i = rho & 15; return 8 * (i >> 2) + 4 * n + (i & 3); }

struct Unit { int pm, pn; };
struct Gemm { const bf16_t* A; const bf16_t* Bt; int M, N, K, lda; };
struct StaticOrder {
    int nM, nN, nwg, G, c;
    __host__ __device__ void init(int M, int N, int G_, int c_) { nM = M / BM; nN = N / BM; nwg = nM * nN; G = G_; c = c_; }
    __host__ __device__ bool next(int i, Unit& u) const {
        const long L = (long)i * G + c; if (L >= nwg) return false;
        int wgid = (int)L; { const int q = nwg / NXCD, r = nwg % NXCD, xcd = wgid % NXCD, off = wgid / NXCD; wgid = (xcd < r ? xcd * (q + 1) : r * (q + 1) + (xcd - r) * q) + off; }
        const int nig = WGM * nN, gid = wgid / nig, fm = gid * WGM, gsz = (nM - fm) < WGM ? (nM - fm) : WGM;
        u.pm = fm + ((wgid % nig) % gsz); u.pn = (wgid % nig) / gsz; return true;
    }
    __device__ __forceinline__ void a_ready(const Unit&) const {}
    __device__ __forceinline__ void done(const Unit&) const {}
};

__device__ __forceinline__ unsigned cvt_pk_bf16(float lo, float hi) { unsigned r; asm volatile("v_cvt_pk_bf16_f32 %0, %1, %2" : "=v"(r) : "v"(lo), "v"(hi)); return r; }
__device__ __forceinline__ float bflo(unsigned w) { return __builtin_bit_cast(float, w << 16); }
__device__ __forceinline__ float bfhi(unsigned w) { return __builtin_bit_cast(float, w & 0xffff0000u); }
__device__ __forceinline__ float sigmoidf_(float v) { return __builtin_amdgcn_rcpf(1.0f + __builtin_amdgcn_exp2f(-1.44269504f * v)); }
struct EpiProj {
    static constexpr bool PERM = true, AFTER_DRAIN = false;
    bf16_t* QKV; bf16_t* G;
    __device__ __forceinline__ void operator()(const f32x4 (&acc)[2][2][4][2], const Unit& u, int wr, int wc, int fr, int fq) const {
        const int row0 = u.pm * BM + wr * 64 + fr; const bool gate = u.pn >= 9;
        bf16_t* base = gate ? G : QKV; const int ldc = gate ? 3072 : 2304; const int col0 = (gate ? (u.pn - 9) : u.pn) * BM + wc * 32 + 8 * fq;
#pragma unroll
        for (int ai = 0; ai < 2; ++ai)
#pragma unroll
            for (int m = 0; m < 4; ++m) { bf16_t* rowp = base + (size_t)(row0 + ai * HALF + m * 16) * ldc + col0;
#pragma unroll
                for (int bj = 0; bj < 2; ++bj) { f32x4 v0 = acc[ai][bj][m][0], v1 = acc[ai][bj][m][1];
                    if (gate) {
#pragma unroll
                        for (int e = 0; e < 4; ++e) { v0[e] = sigmoidf_(v0[e]); v1[e] = sigmoidf_(v1[e]); } }
                    u32x4 w; w.x = cvt_pk_bf16(v0[0], v0[1]); w.y = cvt_pk_bf16(v0[2], v0[3]); w.z = cvt_pk_bf16(v1[0], v1[1]); w.w = cvt_pk_bf16(v1[2], v1[3]);
                    *(u32x4*)(rowp + bj * HALF) = w; } }
    }
};
template <int ACCUM> struct EpiGate {
    static constexpr bool PERM = true, AFTER_DRAIN = false;
    const bf16_t* G; int gcol0; bf16_t* MG;
    __device__ __forceinline__ void operator()(const f32x4 (&acc)[2][2][4][2], const Unit& u, int wr, int wc, int fr, int fq) const {
        const int row0 = u.pm * BM + wr * 64 + fr; const int col0 = u.pn * BM + wc * 32 + 8 * fq;
#pragma unroll
        for (int ai = 0; ai < 2; ++ai)
#pragma unroll
            for (int m = 0; m < 4; ++m) { const size_t r = (size_t)(row0 + ai * HALF + m * 16);
#pragma unroll
                for (int bj = 0; bj < 2; ++bj) { f32x4 v0 = acc[ai][bj][m][0], v1 = acc[ai][bj][m][1];
                    const u32x4 g = *(const u32x4*)(G + r * 3072 + gcol0 + col0 + bj * HALF);
                    v0[0] *= bflo(g.x); v0[1] *= bfhi(g.x); v0[2] *= bflo(g.y); v0[3] *= bfhi(g.y); v1[0] *= bflo(g.z); v1[1] *= bfhi(g.z); v1[2] *= bflo(g.w); v1[3] *= bfhi(g.w);
                    bf16_t* dst = MG + r * 1024 + col0 + bj * HALF;
                    if (ACCUM) { const u32x4 p = *(const u32x4*)dst;
                        v0[0] += bflo(p.x); v0[1] += bfhi(p.x); v0[2] += bflo(p.y); v0[3] += bfhi(p.y); v1[0] += bflo(p.z); v1[1] += bfhi(p.z); v1[2] += bflo(p.w); v1[3] += bfhi(p.w); }
                    u32x4 w; w.x = cvt_pk_bf16(v0[0], v0[1]); w.y = cvt_pk_bf16(v0[2], v0[3]); w.z = cvt_pk_bf16(v1[0], v1[1]); w.w = cvt_pk_bf16(v1[2], v1[3]);
                    *(u32x4*)dst = w; }
                asm volatile("" ::: "memory"); }
    }
};
struct EpiResid {
    static constexpr bool PERM = true, AFTER_DRAIN = false;
    const float* xin; float* out;
    __device__ __forceinline__ void operator()(const f32x4 (&acc)[2][2][4][2], const Unit& u, int wr, int wc, int fr, int fq) const {
        const int row0 = u.pm * BM + wr * 64 + fr; const int col0 = u.pn * BM + wc * 32 + 8 * fq;
#pragma unroll
        for (int ai = 0; ai < 2; ++ai)
#pragma unroll
            for (int m = 0; m < 4; ++m) { const size_t off = (size_t)(row0 + ai * HALF + m * 16) * 1024 + col0;
#pragma unroll
                for (int bj = 0; bj < 2; ++bj) { const float* xi = xin + off + bj * HALF; float* o = out + off + bj * HALF;
                    const f32x4 x0 = *(const f32x4*)xi, x1 = *(const f32x4*)(xi + 4);
                    *(f32x4*)o = x0 + acc[ai][bj][m][0]; *(f32x4*)(o + 4) = x1 + acc[ai][bj][m][1]; }
                asm volatile("" ::: "memory"); }
    }
};
struct EpiUp {
    static constexpr bool PERM = true, AFTER_DRAIN = false;
    bf16_t* U; bf16_t* HALO;
    __device__ __forceinline__ void operator()(const f32x4 (&acc)[2][2][4][2], const Unit& u, int wr, int wc, int fr, int fq) const {
        const int row0 = u.pm * BM + wr * 64 + fr; const int col0 = u.pn * BM + wc * 32 + 8 * fq;
#pragma unroll
        for (int ai = 0; ai < 2; ++ai)
#pragma unroll
            for (int m = 0; m < 4; ++m) { const int row = row0 + ai * HALF + m * 16; bf16_t* rowp = U + (size_t)row * 5632 + col0;
#pragma unroll
                for (int bj = 0; bj < 2; ++bj) { const f32x4 v0 = acc[ai][bj][m][0], v1 = acc[ai][bj][m][1];
                    u32x4 w; w.x = cvt_pk_bf16(v0[0], v0[1]); w.y = cvt_pk_bf16(v0[2], v0[3]); w.z = cvt_pk_bf16(v1[0], v1[1]); w.w = cvt_pk_bf16(v1[2], v1[3]);
                    *(u32x4*)(rowp + bj * HALF) = w;
                    if (m == 3 && fr >= 14) *(u32x4*)(HALO + ((size_t)(row >> 6) * 2 + (fr - 14)) * 5632 + col0 + bj * HALF) = w; } }
    }
};

template <class Epi, class Sched, bool ALIGN_EPI = false, bool SP2 = false>
__device__ __forceinline__ void gemm_phase(PG8_LAS unsigned char* lds, const Gemm g, const Sched& S, const Epi& E) {
    int tid_ = threadIdx.x; asm volatile("" : "+v"(tid_));
    const int tid = tid_, wid = __builtin_amdgcn_readfirstlane(tid >> 6), lane = tid & 63, wr = wid >> 2, wc = wid & 3, fr = lane & 15, fq = lane >> 4;
    const int K = g.K, nt = K / BK;
    unsigned voffA[2], voffB[2];
#pragma unroll
    for (int i = 0; i < 2; ++i) { int R, C; stage_rc(tid * 16 + i * 8192, R, C); const int Rb = Epi::PERM ? ((R & ~31) + perm32(R & 31)) : R;
        voffA[i] = (unsigned)(R * g.lda + C) * 2u; voffB[i] = (unsigned)(Rb * K + C) * 2u; }
    const size_t kstep = (size_t)(BK * 2);
    const size_t hstepA = (size_t)HALF * g.lda * 2, hstepB = (size_t)HALF * K * 2;
    const size_t tstepA = 2 * hstepA, tstepB = 2 * hstepB;
    const unsigned ldsw = (unsigned)wid * 1024u;
    const int aoff = lds_byte(wr * 64 + fr, fq * 8), boff = lds_byte(wc * 32 + fr, fq * 8);
#define PG8_SA(b, h) (((b) * 2 + (h)) * HTB)
#define PG8_SB(b, h) ((4 + (b) * 2 + (h)) * HTB)
#define PG8_STAGE(bufoff, gbase, voff) do { _Pragma("unroll") for (int _i = 0; _i < 2; ++_i) \
        __builtin_amdgcn_global_load_lds((const unsigned*)((const char*)(gbase) + (voff)[_i]), (PG8_LAS unsigned*)(lds + (bufoff) + ldsw + _i * 8192), 16, 0, 0); } while (0)
#define PG8_LDA(dst, b, h) do { _Pragma("unroll") for (int m = 0; m < 4; ++m) _Pragma("unroll") for (int k = 0; k < 2; ++k) dst[m][k] = *(const PG8_LAS bf16x8*)(lds + PG8_SA(b, h) + aoff + m * 2048 + k * 1024); } while (0)
#define PG8_LDB(dst, b, h) do { _Pragma("unroll") for (int n = 0; n < 2; ++n) _Pragma("unroll") for (int k = 0; k < 2; ++k) dst[n][k] = *(const PG8_LAS bf16x8*)(lds + PG8_SB(b, h) + boff + n * 2048 + k * 1024); } while (0)
#define PG8_MMA(ai, bj, At, Bt) do { __builtin_amdgcn_s_setprio(1); _Pragma("unroll") for (int m = 0; m < 4; ++m) _Pragma("unroll") for (int n = 0; n < 2; ++n) _Pragma("unroll") for (int k = 0; k < 2; ++k) \
        acc[ai][bj][m][n] = __builtin_amdgcn_mfma_f32_16x16x32_bf16(Bt[n][k], At[m][k], acc[ai][bj][m][n], 0, 0, 0); __builtin_amdgcn_s_setprio(0); } while (0)
#define PG8_WAIT_V(n) asm volatile("s_waitcnt vmcnt(" #n ")" ::: "memory")
#define PG8_WAIT_L(n) asm volatile("s_waitcnt lgkmcnt(" #n ")" ::: "memory")
#define PG8_BAR __builtin_amdgcn_s_barrier()
#define PG8_SCHED __builtin_amdgcn_sched_barrier(0)
    Unit cur, nxt; int ui = 0;
    if (!S.next(0, cur)) return;
    f32x4 acc[2][2][4][2];
#pragma unroll
    for (int a = 0; a < 2; ++a)
#pragma unroll
        for (int b = 0; b < 2; ++b)
#pragma unroll
            for (int m = 0; m < 4; ++m)
#pragma unroll
                for (int n = 0; n < 2; ++n) acc[a][b][m][n] = (f32x4){0.f, 0.f, 0.f, 0.f};
    bf16x8 At[4][2], B0[2][2], B1[2][2];
    const char* cA = (const char*)g.A + (size_t)cur.pm * tstepA; const char* cB = (const char*)g.Bt + (size_t)cur.pn * tstepB;
    S.a_ready(cur);
    if constexpr (SP2) {
        PG8_STAGE(PG8_SB(0, 0), cB, voffB); PG8_STAGE(PG8_SB(0, 1), cB + hstepB, voffB); PG8_STAGE(PG8_SA(0, 0), cA, voffA); PG8_STAGE(PG8_SA(0, 1), cA + hstepA, voffA);
        if (wr == 1) PG8_BAR;
        PG8_WAIT_V(2); PG8_BAR;
        PG8_STAGE(PG8_SB(1, 0), cB + kstep, voffB); PG8_STAGE(PG8_SA(1, 0), cA + kstep, voffA); PG8_STAGE(PG8_SB(1, 1), cB + hstepB + kstep, voffB);
        PG8_WAIT_V(6); PG8_BAR;
    } else {
        PG8_STAGE(PG8_SB(0, 0), cB, voffB); PG8_STAGE(PG8_SA(0, 0), cA, voffA); PG8_STAGE(PG8_SB(0, 1), cB + hstepB, voffB); PG8_STAGE(PG8_SA(0, 1), cA + hstepA, voffA);
        if (wr == 1) PG8_BAR;
        PG8_WAIT_V(4); PG8_BAR;
        PG8_STAGE(PG8_SB(1, 0), cB + kstep, voffB); PG8_STAGE(PG8_SA(1, 0), cA + kstep, voffA); PG8_STAGE(PG8_SB(1, 1), cB + hstepB + kstep, voffB);
        PG8_WAIT_V(6); PG8_BAR;
    }
    for (;;) {
        const bool has_next = S.next(ui + 1, nxt);
        const char* nA = has_next ? (const char*)g.A + (size_t)nxt.pm * tstepA : cA; const char* nB = has_next ? (const char*)g.Bt + (size_t)nxt.pn * tstepB : cB;
        for (int t = 0; t < nt; t += 2) {
            const bool last = (t == nt - 2);
            const char* a1 = cA + (size_t)(t + 1) * kstep;
            const char* a2 = last ? nA : cA + (size_t)(t + 2) * kstep; const char* b2 = last ? nB : cB + (size_t)(t + 2) * kstep;
            const char* a3 = a2 + kstep; const char* b3 = b2 + kstep;
            if (last && has_next) S.a_ready(nxt);
            if constexpr (SP2) {
            PG8_LDB(B0, 0, 0); PG8_LDB(B1, 0, 1); PG8_SCHED; PG8_LDA(At, 0, 0); PG8_STAGE(PG8_SA(1, 1), a1 + hstepA, voffA);
            PG8_WAIT_V(8); PG8_WAIT_L(0); PG8_BAR; PG8_MMA(0, 0, At, B0); PG8_MMA(0, 1, At, B1); PG8_BAR; PG8_SCHED;
            PG8_LDA(At, 0, 1); PG8_STAGE(PG8_SB(0, 0), b2, voffB); PG8_STAGE(PG8_SB(0, 1), b2 + hstepB, voffB); PG8_STAGE(PG8_SA(0, 0), a2, voffA);
            PG8_WAIT_V(8); PG8_WAIT_L(0); PG8_BAR; PG8_MMA(1, 0, At, B0); PG8_MMA(1, 1, At, B1); PG8_BAR; PG8_SCHED;
            PG8_LDB(B0, 1, 0); PG8_LDB(B1, 1, 1); PG8_SCHED; PG8_LDA(At, 1, 0); PG8_STAGE(PG8_SA(0, 1), a2 + hstepA, voffA);
            PG8_WAIT_V(8); PG8_WAIT_L(0); PG8_BAR; PG8_MMA(0, 0, At, B0); PG8_MMA(0, 1, At, B1); PG8_BAR; PG8_SCHED;
            PG8_LDA(At, 1, 1); PG8_STAGE(PG8_SB(1, 0), b3, voffB); PG8_STAGE(PG8_SB(1, 1), b3 + hstepB, voffB); PG8_STAGE(PG8_SA(1, 0), a3, voffA);
            PG8_WAIT_V(8); PG8_WAIT_L(0); PG8_BAR; PG8_MMA(1, 0, At, B0); PG8_MMA(1, 1, At, B1); PG8_BAR; PG8_SCHED;
            } else {
            PG8_LDB(B0, 0, 0); PG8_SCHED; PG8_LDA(At, 0, 0); PG8_STAGE(PG8_SA(1, 1), a1 + hstepA, voffA);
            PG8_WAIT_L(8); PG8_BAR; PG8_WAIT_L(0); PG8_MMA(0, 0, At, B0); PG8_BAR; PG8_SCHED;
            PG8_LDB(B1, 0, 1); PG8_STAGE(PG8_SB(0, 0), b2, voffB);
            PG8_BAR; PG8_WAIT_L(0); PG8_MMA(0, 1, At, B1); PG8_BAR;
            PG8_LDA(At, 0, 1); PG8_STAGE(PG8_SA(0, 0), a2, voffA);
            PG8_BAR; PG8_WAIT_L(0); PG8_MMA(1, 0, At, B0); PG8_BAR; PG8_SCHED;
            PG8_STAGE(PG8_SB(0, 1), b2 + hstepB, voffB);
            PG8_WAIT_V(6); PG8_BAR; PG8_MMA(1, 1, At, B1); PG8_BAR;
            PG8_LDB(B0, 1, 0); PG8_SCHED; PG8_LDA(At, 1, 0); PG8_STAGE(PG8_SA(0, 1), a2 + hstepA, voffA);
            PG8_WAIT_L(8); PG8_BAR; PG8_WAIT_L(0); PG8_MMA(0, 0, At, B0); PG8_BAR; PG8_SCHED;
            PG8_LDB(B1, 1, 1); PG8_STAGE(PG8_SB(1, 0), b3, voffB);
            PG8_BAR; PG8_WAIT_L(0); PG8_MMA(0, 1, At, B1); PG8_BAR;
            PG8_LDA(At, 1, 1); PG8_STAGE(PG8_SA(1, 0), a3, voffA);
            PG8_BAR; PG8_WAIT_L(0); PG8_MMA(1, 0, At, B0); PG8_BAR; PG8_SCHED;
            PG8_STAGE(PG8_SB(1, 1), b3 + hstepB, voffB);
            PG8_WAIT_V(6); PG8_BAR; PG8_MMA(1, 1, At, B1); PG8_BAR;
            }
        }
        if constexpr (ALIGN_EPI) { if (wr == 0) PG8_BAR; }
        if constexpr (!Epi::AFTER_DRAIN) { E(acc, cur, wr, wc, fr, fq); S.done(cur); }
        if (!has_next) break;
#pragma unroll
        for (int a = 0; a < 2; ++a)
#pragma unroll
            for (int b = 0; b < 2; ++b)
#pragma unroll
                for (int m = 0; m < 4; ++m)
#pragma unroll
                    for (int n = 0; n < 2; ++n) acc[a][b][m][n] = (f32x4){0.f, 0.f, 0.f, 0.f};
        cur = nxt; cA = nA; cB = nB; ++ui;
        if constexpr (ALIGN_EPI) { if (wr == 1) PG8_BAR; }
    }
    PG8_WAIT_V(0);
    if constexpr (!ALIGN_EPI) { if (wr == 0) PG8_BAR; }
    PG8_BAR;
    if constexpr (Epi::AFTER_DRAIN) { E.fused(acc, cur, wr, wc, fr, fq, lds, wid, lane); S.done(cur); }
#undef PG8_SA
#undef PG8_SB
#undef PG8_STAGE
#undef PG8_LDA
#undef PG8_LDB
#undef PG8_MMA
#undef PG8_WAIT_V
#undef PG8_WAIT_L
#undef PG8_BAR
#undef PG8_SCHED
}
}

#define LAS __attribute__((address_space(3)))
typedef unsigned short bf16;
typedef short bf16x8 __attribute__((ext_vector_type(8)));
typedef float f32x4 __attribute__((ext_vector_type(4)));
typedef float f32x16 __attribute__((ext_vector_type(16)));
typedef unsigned u32x4 __attribute__((ext_vector_type(4)));
typedef unsigned u32x2 __attribute__((ext_vector_type(2)));
constexpr int SEQ = 8192, MTOK = 16384, DM = 1024, NIN = 5376, NQKV = 2304, NGATE = 3072, FF = 2816, FF2 = 5632;
constexpr size_t MiB = 1u << 20;
constexpr size_t WS_CTL = 0, WS_KMP = 64 * 1024;
constexpr size_t WS_W = 1 * MiB;
constexpr size_t W_IN = 0, W_PA = W_IN + (size_t)NIN * DM * 2, W_PB = W_PA + 1024 * 256 * 2, W_PC = W_PB + 1024 * 512 * 2, W_OUT = W_PC + 1024 * 256 * 2,
                 W_UP = W_OUT + 1024 * 1024 * 2, W_DOWN = W_UP + (size_t)FF2 * DM * 2, W_END = W_DOWN + (size_t)DM * FF * 2;
static_assert(W_END <= 31 * MiB, "weights");
constexpr size_t WS_H = 32 * MiB;
constexpr size_t WS_G = 64 * MiB;
constexpr size_t WS_QKV = 160 * MiB;
constexpr size_t WS_VT = 232 * MiB;
constexpr size_t WS_U = 64 * MiB;
constexpr size_t WS_HALO = 240 * MiB;
constexpr size_t WS_END = 252 * MiB;
constexpr int LDS_BYTES = 147456;
constexpr int NPH = 20;

struct Args {
    const float* in[24]; float* out; unsigned char* ws;
    float inv64[32]; float inv32[16]; float lam_init[2];
    int ph_lo, ph_hi;
};
enum { I_X = 0, I_ATTN_NORM, I_W_IN, I_QN_A, I_KN_A, I_QN_B, I_KN_B, I_SINKS, I_QN_C, I_KN_C, I_LQ1, I_LK1, I_LQ2, I_LK2, I_SUBLN, I_WPA, I_WPB, I_WPC, I_WOUT, I_MLP_NORM, I_WUP, I_CONVW, I_CONVB, I_WDOWN };

template <class T> __device__ __forceinline__ T* sptr(T* p) { const unsigned long long v = (unsigned long long)p;
    const unsigned lo = __builtin_amdgcn_readfirstlane((unsigned)v), hi = __builtin_amdgcn_readfirstlane((unsigned)(v >> 32)); return (T*)(((unsigned long long)hi << 32) | lo); }

__device__ __forceinline__ unsigned f2bf(float f) { unsigned u = __builtin_bit_cast(unsigned, f); return (u + 0x7fffu + ((u >> 16) & 1u)) >> 16; }
__device__ __forceinline__ unsigned pk2(float lo, float hi) { return pg8::cvt_pk_bf16(lo, hi); }
__device__ __forceinline__ float bf2f(unsigned short v) { return __builtin_bit_cast(float, (unsigned)v << 16); }
__device__ __forceinline__ float wave_sum(float v) {
#pragma unroll
    for (int o = 1; o < 64; o <<= 1) v += __shfl_xor(v, o);
    return v;
}
#define LDS_WAIT() asm volatile("s_waitcnt lgkmcnt(0)" ::: "memory")

__device__ __forceinline__ void transpose_item(const float* W, int K, int N, bf16* WT, LAS float* scr, int item, int lane) {
    const int nblk = N / 32, kb = item / nblk, nb = item % nblk, k0 = 64 * kb, n0 = 32 * nb;
#pragma unroll 8
    for (int i = 0; i < 32; ++i) { const int kk = 2 * i + (lane >> 5); scr[kk * 33 + (lane & 31)] = W[(size_t)(k0 + kk) * N + n0 + (lane & 31)]; }
    LDS_WAIT(); asm volatile("" ::: "memory");
    const int c = lane & 7;
#pragma unroll
    for (int j = 0; j < 4; ++j) { const int n = (lane >> 3) + 8 * j; const LAS float* s = scr + (8 * c) * 33 + n;
        u32x4 o; o.x = pk2(s[0 * 33], s[1 * 33]); o.y = pk2(s[2 * 33], s[3 * 33]); o.z = pk2(s[4 * 33], s[5 * 33]); o.w = pk2(s[6 * 33], s[7 * 33]);
        *(u32x4*)(WT + (size_t)(n0 + n) * K + k0 + 8 * c) = o; }
    LDS_WAIT(); asm volatile("" ::: "memory");
}
__device__ __forceinline__ void rms_row_to_bf16(const float* xrow, const float* gain, bf16* orow, int lane) {
    const f32x4* xr = (const f32x4*)xrow + lane; const f32x4* gr = (const f32x4*)gain + lane;
    f32x4 v[4]; float s = 0.f;
#pragma unroll
    for (int j = 0; j < 4; ++j) { v[j] = xr[64 * j]; s += (v[j].x * v[j].x + v[j].y * v[j].y) + (v[j].z * v[j].z + v[j].w * v[j].w); }
    const float rinv = 1.0f / sqrtf(wave_sum(s) * (1.f / DM) + 1e-6f);
    unsigned long long* o8 = (unsigned long long*)orow + lane;
#pragma unroll
    for (int j = 0; j < 4; ++j) { const f32x4 g = gr[64 * j];
        o8[64 * j] = (unsigned long long)pk2(v[j].x * rinv * g.x, v[j].y * rinv * g.y) | ((unsigned long long)pk2(v[j].z * rinv * g.z, v[j].w * rinv * g.w) << 32); }
}

__device__ __forceinline__ void phase_convert(const LAS Args& a, int layer, LAS unsigned char* lds) {
    int tid_ = threadIdx.x; asm volatile("" : "+v"(tid_));
    const int lane = tid_ & 63, wave = tid_ >> 6, gw = blockIdx.x * 8 + wave, NGW = gridDim.x * 8;
    LAS float* scr = (LAS float*)(lds + wave * 16384);
    bf16* Wb = (bf16*)(sptr(a.ws) + WS_W);
    constexpr int I0 = 16 * (NIN / 32), I1 = 4 * 32, I2 = 8 * 32, I3 = 4 * 32, I4 = 16 * 32, I5 = 16 * (FF2 / 32), I6 = (FF / 64) * 32;
    constexpr int NIT = I0 + I1 + I2 + I3 + I4 + I5 + I6;
    for (int it = gw; it < NIT; it += NGW) {
        int r = it;
        if (r < I0) { transpose_item(sptr(a.in[I_W_IN]) + (size_t)layer * DM * NIN, DM, NIN, (bf16*)((char*)Wb + W_IN), scr, r, lane); continue; } r -= I0;
        if (r < I1) { transpose_item(sptr(a.in[I_WPA]) + (size_t)layer * 256 * DM, 256, DM, (bf16*)((char*)Wb + W_PA), scr, r, lane); continue; } r -= I1;
        if (r < I2) { transpose_item(sptr(a.in[I_WPB]) + (size_t)layer * 512 * DM, 512, DM, (bf16*)((char*)Wb + W_PB), scr, r, lane); continue; } r -= I2;
        if (r < I3) { transpose_item(sptr(a.in[I_WPC]) + (size_t)layer * 256 * DM, 256, DM, (bf16*)((char*)Wb + W_PC), scr, r, lane); continue; } r -= I3;
        if (r < I4) { transpose_item(sptr(a.in[I_WOUT]) + (size_t)layer * DM * DM, DM, DM, (bf16*)((char*)Wb + W_OUT), scr, r, lane); continue; } r -= I4;
        if (r < I5) { transpose_item(sptr(a.in[I_WUP]) + (size_t)layer * DM * FF2, DM, FF2, (bf16*)((char*)Wb + W_UP), scr, r, lane); continue; } r -= I5;
        transpose_item(sptr(a.in[I_WDOWN]) + (size_t)layer * FF * DM, FF, DM, (bf16*)((char*)Wb + W_DOWN), scr, r, lane);
    }
}
__device__ __forceinline__ void phase_norm(const float* x, const float* gain, bf16* H) {
    int tid_ = threadIdx.x; asm volatile("" : "+v"(tid_));
    const int lane = tid_ & 63, wave = tid_ >> 6, gw = blockIdx.x * 8 + wave, NGW = gridDim.x * 8;
    for (int m = gw; m < MTOK; m += NGW) rms_row_to_bf16(x + (size_t)m * DM, gain, H + (size_t)m * DM, lane);
}

__device__ __forceinline__ void sincos_rev(float ang, float& s, float& c) {
    const float k = rintf(ang * 0.15915494309f);
    float r = fmaf(-k, 6.28125f, ang); r = fmaf(-k, 1.9353071795864769e-3f, r);
    const float f = r * 0.15915494309f;
    s = __builtin_amdgcn_sinf(f); c = __builtin_amdgcn_cosf(f);
}
__device__ __forceinline__ void phase_prep(const LAS Args& a, int layer, LAS unsigned char* lds) {
    int tid_ = threadIdx.x; asm volatile("" : "+v"(tid_));
    const int tid = tid_, lane = tid & 63, wave = tid >> 6;
    bf16* QKV = (bf16*)(sptr(a.ws) + WS_QKV); bf16* VT = (bf16*)(sptr(a.ws) + WS_VT); float* KMP = (float*)(sptr(a.ws) + WS_KMP);
    LAS unsigned short* vt = (LAS unsigned short*)lds;
    LAS float* kms = (LAS float*)(lds + 10 * 64 * 68 * 2);
    const float gqa = sptr(a.in[I_QN_A])[layer * 64 + lane], gka = sptr(a.in[I_KN_A])[layer * 64 + lane], gqb = sptr(a.in[I_QN_B])[layer * 64 + lane], gkb = sptr(a.in[I_KN_B])[layer * 64 + lane];
    const float gqc = sptr(a.in[I_QN_C])[layer * 32 + (lane & 31)], gkc = sptr(a.in[I_KN_C])[layer * 32 + (lane & 31)];
    const float iv64 = a.inv64[lane & 31], iv32 = a.inv32[lane & 15];
    const float sg64 = (lane & 32) ? 1.f : -1.f, sg32 = (lane & 16) ? 1.f : -1.f;
    const float QS64 = 0.125f * 1.44269504f, QS32 = 0.17677669529f * 1.44269504f;
    for (int c = blockIdx.x; c < MTOK / 64; c += gridDim.x) {
        const int tb = 64 * c, b = tb / SEQ, spos0 = tb % SEQ;
        float kacc[4] = {0.f, 0.f, 0.f, 0.f};
        for (int i = 0; i < 8; ++i) {
            const int p64 = wave * 8 + i, tok = tb + p64, pos = spos0 + p64;
            bf16* row = QKV + (size_t)tok * NQKV;
            float v[36];
#pragma unroll
            for (int s = 0; s < 36; ++s) v[s] = bf2f(row[64 * s + lane]);
            float s64, c64, s32, c32; sincos_rev((float)pos * iv64, s64, c64); sincos_rev((float)pos * iv32, s32, c32);
            s64 *= sg64; s32 *= sg32;
            const int k16 = p64 & 15, ppos = (p64 & ~15) | (8 * ((k16 >> 2) & 1) + 4 * ((k16 >> 3) & 1) + (k16 & 3));
#pragma unroll
            for (int s = 0; s < 36; ++s) {
                const bool isv = (s >= 8 && s < 12) || (s >= 22 && s < 24) || (s >= 32);
                if (isv) { const int hv = s < 12 ? s - 8 : (s < 24 ? 4 + s - 22 : 6 + s - 32); vt[(hv * 64 + lane) * 68 + ppos] = (unsigned short)f2bf(v[s]); continue; }
                const bool isc = s >= 24;
                float x = v[s], ss = x * x;
                ss += __shfl_xor(ss, 1); ss += __shfl_xor(ss, 2); ss += __shfl_xor(ss, 4); ss += __shfl_xor(ss, 8); ss += __shfl_xor(ss, 16);
                if (!isc) ss += __shfl_xor(ss, 32);
                const float rinv = 1.0f / sqrtf(ss * (isc ? (1.f / 32.f) : (1.f / 64.f)) + 1e-6f);
                float g, qs = 1.f;
                if (s < 4) { g = gqa; qs = QS64; } else if (s < 8) g = gka; else if (s < 20) { g = gqb; qs = QS64; } else if (s < 22) g = gkb; else if (s < 28) { g = gqc; qs = QS32; } else g = gkc;
                x = x * rinv * g;
                const float partner = __shfl_xor(x, isc ? 16 : 32);
                const float y = isc ? (x * c32 + partner * s32) : (x * c64 + partner * s64);
                if (s >= 4 && s < 8) kacc[s - 4] += y;
                row[64 * s + lane] = (unsigned short)f2bf(y * qs);
            }
        }
#pragma unroll
        for (int h = 0; h < 4; ++h) kms[(wave * 4 + h) * 64 + lane] = kacc[h];
        __syncthreads();
        if (tid < 256) { float s = 0.f;
#pragma unroll
            for (int w = 0; w < 8; ++w) s += kms[w * 256 + tid];
            KMP[(size_t)c * 256 + tid] = s; }
#pragma unroll
        for (int j = 0; j < 10; ++j) { const int idx = tid + 512 * j, r = idx >> 3, ch = idx & 7, hv = r >> 6, dv = r & 63;
            const LAS u32x2* src = (const LAS u32x2*)(lds + (size_t)r * 136 + ch * 16);
            const u32x2 lo = src[0], hi = src[1]; u32x4 o; o.x = lo.x; o.y = lo.y; o.z = hi.x; o.w = hi.y;
            *(u32x4*)(VT + (((size_t)b * 10 + hv) * 64 + dv) * SEQ + spos0 + 8 * ch) = o; }
        __syncthreads();
    }
}

#ifndef ATM
#define ATM 7
#endif
#define MFMA32(a, b, c) __builtin_amdgcn_mfma_f32_32x32x16_bf16((a), (b), (c), 0, 0, 0)
__device__ __forceinline__ bf16x8 pack8(float p0, float p1, float p2, float p3, float p4, float p5, float p6, float p7) {
    u32x4 p;
    asm volatile("v_cvt_pk_bf16_f32 %0, %4, %5\n\tv_cvt_pk_bf16_f32 %1, %6, %7\n\tv_cvt_pk_bf16_f32 %2, %8, %9\n\tv_cvt_pk_bf16_f32 %3, %10, %11\n\ts_nop 1"
                 : "=&v"(p[0]), "=&v"(p[1]), "=&v"(p[2]), "=&v"(p[3]) : "v"(p0), "v"(p1), "v"(p2), "v"(p3), "v"(p4), "v"(p5), "v"(p6), "v"(p7));
    return __builtin_bit_cast(bf16x8, p);
}
constexpr int AT_K = 0, AT_V = 18432, AT_KM = 36864, AT_MISC = 45056;
constexpr int NUNITS = 1024;

template <int MODE>
__device__ __forceinline__ void attn_unit(const LAS Args& a, int layer, LAS unsigned char* lds, int b, int head, int qt) {
    int tid_ = threadIdx.x; asm volatile("" : "+v"(tid_));
    const int tid = tid_, lane = tid & 63, wave = __builtin_amdgcn_readfirstlane(tid >> 6), qrow = lane & 31, hh = lane >> 5;
    const int q0 = qt * 256, q0w = q0 + wave * 32, qpos = q0w + qrow;
    const size_t tok = (size_t)b * SEQ + qpos;
    const bf16* QKV = (const bf16*)(sptr(a.ws) + WS_QKV); const bf16* VT = (const bf16*)(sptr(a.ws) + WS_VT); bf16* Y = (bf16*)(sptr(a.ws) + WS_H);
    const int qcol = MODE == 0 ? head * 64 : (MODE == 1 ? 768 + head * 64 : 1536 + head * 64);
    const int kcol = MODE == 0 ? 256 + head * 64 : (MODE == 1 ? 1280 + (head >> 2) * 64 : 1792 + head * 64);
    const int hv = MODE == 0 ? head : (MODE == 1 ? 4 + (head >> 2) : 6 + head);
    const int ycol = MODE == 0 ? head * 64 : (MODE == 1 ? 256 + head * 64 : 768 + head * 64);
    volatile LAS unsigned* misc = (volatile LAS unsigned*)(lds + AT_MISC);
    bf16x8 qf[4];
#pragma unroll
    for (int i = 0; i < 4; ++i) qf[i] = *(const bf16x8*)(QKV + tok * NQKV + qcol + 16 * i + 8 * hh);
    unsigned mymask = 0u, umask = 0u;
    if (MODE == 0) {
        if (qt <= 3) { mymask = (1u << qt) - 1u; umask = mymask; }
        else {
            LAS float* kml = (LAS float*)(lds + AT_KM);
            const float* KMP = (const float*)(sptr(a.ws) + WS_KMP);
            for (int idx = tid; idx < qt * 64; idx += 512) { const int j = idx >> 6, d = idx & 63; const float* p = KMP + ((size_t)(b * 128 + 4 * j) * 4 + head) * 64 + d;
                kml[idx] = (p[0] + p[256] + p[512] + p[768]) * (1.f / 256.f); }
            if (tid == 0) misc[2] = 0u;
            __syncthreads();
            float qv[32];
#pragma unroll
            for (int i = 0; i < 4; ++i) { const u32x4 w = *(const u32x4*)(QKV + tok * NQKV + qcol + 32 * hh + 8 * i);
                qv[8 * i + 0] = pg8::bflo(w.x); qv[8 * i + 1] = pg8::bfhi(w.x); qv[8 * i + 2] = pg8::bflo(w.y); qv[8 * i + 3] = pg8::bfhi(w.y);
                qv[8 * i + 4] = pg8::bflo(w.z); qv[8 * i + 5] = pg8::bfhi(w.z); qv[8 * i + 6] = pg8::bflo(w.w); qv[8 * i + 7] = pg8::bfhi(w.w); }
            float v0 = -INFINITY, v1 = -INFINITY, v2 = -INFINITY; int i0 = 0, i1 = 0, i2 = 0;
            for (int j = 0; j < qt; ++j) {
                const LAS f32x4* kr = (const LAS f32x4*)(kml + j * 64 + 32 * hh);
                float acc = 0.f;
#pragma unroll
                for (int i = 0; i < 8; ++i) { const f32x4 kk = kr[i]; acc += qv[4 * i] * kk.x + qv[4 * i + 1] * kk.y + qv[4 * i + 2] * kk.z + qv[4 * i + 3] * kk.w; }
                const float g = acc + __shfl_xor(acc, 32);
                if (g > v0) { v2 = v1; i2 = i1; v1 = v0; i1 = i0; v0 = g; i0 = j; }
                else if (g > v1) { v2 = v1; i2 = i1; v1 = g; i1 = j; }
                else if (g > v2) { v2 = g; i2 = j; }
            }
            mymask = (1u << i0) | (1u << i1) | (1u << i2);
            atomicOr((unsigned*)(lds + AT_MISC) + 2, mymask);
            __syncthreads();
            umask = misc[2];
        }
    }
    float lam = 0.f, sinkv = 0.f;
    if (MODE == 2) { float t1 = 0.f, t2 = 0.f;
        if (lane < 32) { t1 = sptr(a.in[I_LQ1])[layer * 32 + lane] * sptr(a.in[I_LK1])[layer * 32 + lane]; t2 = sptr(a.in[I_LQ2])[layer * 32 + lane] * sptr(a.in[I_LK2])[layer * 32 + lane]; }
        lam = expf(wave_sum(t1)) - expf(wave_sum(t2)) + a.lam_init[layer]; }
    if (MODE == 1) sinkv = __builtin_amdgcn_exp2f(sptr(a.in[I_SINKS])[layer * 8 + head] * 1.44269504f);

    const int kt_hi = 4 * (qt + 1);
    int kt = 0;
    if (MODE == 1) kt = q0 >= 128 ? (q0 - 128) / 64 : 0;
#define VALID_TILE(t) (MODE != 0 || ((t) >> 2) == qt || ((umask >> ((t) >> 2)) & 1u))
    while (!VALID_TILE(kt)) ++kt;
    const int lrow = tid >> 3, lch = tid & 7;
    const bf16* kg = QKV + ((size_t)b * SEQ + lrow) * NQKV + kcol + 8 * lch;
    const bf16* vg = VT + (((size_t)b * 10 + hv) * 64 + lrow) * SEQ + 8 * lch;
    const int st_off = lrow * 144 + lch * 16;
    u32x4 kreg = *(const u32x4*)(kg + (size_t)(kt * 64) * NQKV), vreg = *(const u32x4*)(vg + kt * 64);
    *(LAS u32x4*)(lds + AT_K + st_off) = kreg; *(LAS u32x4*)(lds + AT_V + st_off) = vreg;
    __syncthreads();
    f32x16 o1[2], o2[2]; float l1 = 0.f, l2 = 0.f;
#pragma unroll
    for (int d = 0; d < 2; ++d)
#pragma unroll
        for (int i = 0; i < 16; ++i) { o1[d][i] = 0.f; o2[d][i] = 0.f; }
    int buf = 0;
    while (kt < kt_hi) {
        int nkt = kt + 1;
        while (nkt < kt_hi && !VALID_TILE(nkt)) ++nkt;
        const bool has_next = nkt < kt_hi;
        if (has_next) { kreg = *(const u32x4*)(kg + (size_t)(nkt * 64) * NQKV); vreg = *(const u32x4*)(vg + nkt * 64); }
#pragma unroll 1
        for (int sub = 0; sub < 2; ++sub) {
            const int k0s = kt * 64 + 32 * sub;
            bool skip, needmask = false, past = false; unsigned uwin = 0x7fffffffu; bool bit = true;
            if (MODE == 1) { skip = (k0s > q0w + 31) || (k0s + 31 + 127 < q0w); needmask = !((k0s + 31 <= q0w) && (k0s + 127 >= q0w + 31)); uwin = 128u; }
            else if (MODE == 0 && (kt >> 2) != qt) { past = true; bit = (mymask >> (kt >> 2)) & 1u; skip = (__ballot(bit) == 0ull); }
            else { skip = k0s > q0w + 31; needmask = k0s + 31 > q0w; }
            if (skip) continue;
            f32x16 S1, S2;
#pragma unroll
            for (int i = 0; i < 16; ++i) { S1[i] = 0.f; S2[i] = 0.f; }
            const LAS unsigned char* kb = lds + AT_K + buf * 9216 + (32 * sub + qrow) * 144 + hh * 16;
#pragma unroll
            for (int i = 0; i < 4; ++i) { const bf16x8 kf = *(const LAS bf16x8*)(kb + i * 32);
                if (MODE == 2 && i >= 2) S2 = MFMA32(kf, qf[i], S2); else S1 = MFMA32(kf, qf[i], S1); }
            const int dbase = qpos - k0s - 4 * hh;
            float p1[16], p2[16];
#pragma unroll
            for (int i = 0; i < 16; ++i) {
                const int ci = (i & 3) + 8 * (i >> 2);
                float e1 = __builtin_amdgcn_exp2f(S1[i]), e2 = 0.f;
                if (MODE == 2) e2 = __builtin_amdgcn_exp2f(S2[i]);
                if (needmask) { const bool ok = (unsigned)(dbase - ci) < uwin; e1 = ok ? e1 : 0.f; e2 = ok ? e2 : 0.f; }
                if (past) e1 = bit ? e1 : 0.f;
                l1 += e1; p1[i] = e1;
                if (MODE == 2) { l2 += e2; p2[i] = e2; }
            }
            bf16x8 pf1[2], pf2[2];
#pragma unroll
            for (int s = 0; s < 2; ++s) { pf1[s] = pack8(p1[8 * s], p1[8 * s + 1], p1[8 * s + 2], p1[8 * s + 3], p1[8 * s + 4], p1[8 * s + 5], p1[8 * s + 6], p1[8 * s + 7]);
                if (MODE == 2) pf2[s] = pack8(p2[8 * s], p2[8 * s + 1], p2[8 * s + 2], p2[8 * s + 3], p2[8 * s + 4], p2[8 * s + 5], p2[8 * s + 6], p2[8 * s + 7]); }
            const LAS unsigned char* vb = lds + AT_V + buf * 9216 + qrow * 144 + (32 * sub + 8 * hh) * 2;
#pragma unroll
            for (int d = 0; d < 2; ++d)
#pragma unroll
                for (int s = 0; s < 2; ++s) { const bf16x8 vf = *(const LAS bf16x8*)(vb + d * (32 * 144) + s * 32);
                    o1[d] = MFMA32(vf, pf1[s], o1[d]);
                    if (MODE == 2) o2[d] = MFMA32(vf, pf2[s], o2[d]); }
        }
        if (has_next) { *(LAS u32x4*)(lds + AT_K + (buf ^ 1) * 9216 + st_off) = kreg; *(LAS u32x4*)(lds + AT_V + (buf ^ 1) * 9216 + st_off) = vreg; }
        __syncthreads();
        buf ^= 1; kt = nkt;
    }
#undef VALID_TILE
    l1 += __shfl_xor(l1, 32);
    if (MODE == 1) l1 += sinkv;
    const float inv1 = 1.0f / l1;
    bf16* yrow = Y + tok * DM + ycol + 4 * hh;
    if (MODE != 2) {
#pragma unroll
        for (int d = 0; d < 2; ++d)
#pragma unroll
            for (int g = 0; g < 4; ++g) { u32x2 w; w.x = pk2(o1[d][4 * g] * inv1, o1[d][4 * g + 1] * inv1); w.y = pk2(o1[d][4 * g + 2] * inv1, o1[d][4 * g + 3] * inv1);
                *(u32x2*)(yrow + 32 * d + 8 * g) = w; }
    } else {
        l2 += __shfl_xor(l2, 32);
        const float c2 = lam / l2; float ss = 0.f;
#pragma unroll
        for (int d = 0; d < 2; ++d)
#pragma unroll
            for (int i = 0; i < 16; ++i) { const float o = o1[d][i] * inv1 - o2[d][i] * c2; o1[d][i] = o; ss += o * o; }
        ss += __shfl_xor(ss, 32);
        const float r = (1.0f - a.lam_init[layer]) / sqrtf(ss * (1.f / 64.f) + 1e-6f);
        const float* sg = sptr(a.in[I_SUBLN]) + layer * 64 + 4 * hh;
#pragma unroll
        for (int d = 0; d < 2; ++d)
#pragma unroll
            for (int g = 0; g < 4; ++g) { const f32x4 gg = *(const f32x4*)(sg + 32 * d + 8 * g);
                u32x2 w; w.x = pk2(o1[d][4 * g] * r * gg.x, o1[d][4 * g + 1] * r * gg.y); w.y = pk2(o1[d][4 * g + 2] * r * gg.z, o1[d][4 * g + 3] * r * gg.w);
                *(u32x2*)(yrow + 32 * d + 8 * g) = w; }
    }
}
__device__ __forceinline__ void phase_attn(const LAS Args& a, int layer, LAS unsigned char* lds) {
    unsigned* queue = (unsigned*)(sptr(a.ws) + WS_CTL) + 64 * layer;
    volatile LAS unsigned* misc = (volatile LAS unsigned*)(lds + AT_MISC);
    for (;;) {
        if (threadIdx.x == 0) misc[0] = atomicAdd(queue, 1u);
        __syncthreads();
        const unsigned u = misc[0];
        __syncthreads();
        if (u >= (unsigned)NUNITS) break;
        if (u < 512u) { const int qt = 31 - (int)(u >> 4), r = u & 15, bh = r & 7;
            if (r < 8) { if (ATM & 4) attn_unit<2>(a, layer, lds, bh >> 2, bh & 3, qt); } else { if (ATM & 1) attn_unit<0>(a, layer, lds, bh >> 2, bh & 3, qt); } }
        else { const int v = (int)u - 512, qt = 31 - (v >> 4), r = v & 15; if (ATM & 2) attn_unit<1>(a, layer, lds, r >> 3, r & 7, qt); }
    }
}

__device__ __forceinline__ void unpack8(const u32x4 w, float (&f)[8]) {
    f[0] = pg8::bflo(w.x); f[1] = pg8::bfhi(w.x); f[2] = pg8::bflo(w.y); f[3] = pg8::bfhi(w.y); f[4] = pg8::bflo(w.z); f[5] = pg8::bfhi(w.z); f[6] = pg8::bflo(w.w); f[7] = pg8::bfhi(w.w);
}
__device__ __forceinline__ void phase_conv(const LAS Args& a, int layer) {
    int tid_ = threadIdx.x; asm volatile("" : "+v"(tid_));
    const int tid = tid_;
    if (tid >= FF / 8) return;
    bf16* U = (bf16*)(sptr(a.ws) + WS_U); const bf16* HALO = (const bf16*)(sptr(a.ws) + WS_HALO);
    const int ch0 = tid * 8;
    const float* cw = sptr(a.in[I_CONVW]) + (size_t)layer * 3 * FF2; const float* cb = sptr(a.in[I_CONVB]) + (size_t)layer * FF2;
    float wg[3][8], wv[3][8], bg[8], bv[8];
#pragma unroll
    for (int e = 0; e < 8; ++e) {
#pragma unroll
        for (int j = 0; j < 3; ++j) { wg[j][e] = cw[j * FF2 + ch0 + e]; wv[j][e] = cw[j * FF2 + FF + ch0 + e]; }
        bg[e] = cb[ch0 + e]; bv[e] = cb[FF + ch0 + e]; }
    for (int c = blockIdx.x; c < MTOK / 64; c += gridDim.x) {
        float g2[8], g1[8], v2[8], v1[8];
        if ((c * 64) % SEQ == 0) {
#pragma unroll
            for (int e = 0; e < 8; ++e) { g2[e] = 0.f; g1[e] = 0.f; v2[e] = 0.f; v1[e] = 0.f; }
        } else { const bf16* hp = HALO + (size_t)(c - 1) * 2 * FF2;
            unpack8(*(const u32x4*)(hp + ch0), g2); unpack8(*(const u32x4*)(hp + FF + ch0), v2);
            unpack8(*(const u32x4*)(hp + FF2 + ch0), g1); unpack8(*(const u32x4*)(hp + FF2 + FF + ch0), v1); }
        for (int rg = 0; rg < 16; ++rg) {
            bf16* rp = U + (size_t)(c * 64 + rg * 4) * FF2;
            u32x4 gw[4], vw[4];
#pragma unroll
            for (int r = 0; r < 4; ++r) { gw[r] = *(const u32x4*)(rp + (size_t)r * FF2 + ch0); vw[r] = *(const u32x4*)(rp + (size_t)r * FF2 + FF + ch0); }
#pragma unroll
            for (int r = 0; r < 4; ++r) {
                float g0[8], v0[8], o[8]; unpack8(gw[r], g0); unpack8(vw[r], v0);
#pragma unroll
                for (int e = 0; e < 8; ++e) {
                    const float yg = bg[e] + wg[0][e] * g2[e] + wg[1][e] * g1[e] + wg[2][e] * g0[e];
                    const float yv = bv[e] + wv[0][e] * v2[e] + wv[1][e] * v1[e] + wv[2][e] * v0[e];
                    o[e] = yg * pg8::sigmoidf_(yg) * yv;
                    g2[e] = g1[e]; g1[e] = g0[e]; v2[e] = v1[e]; v1[e] = v0[e]; }
                u32x4 w; w.x = pk2(o[0], o[1]); w.y = pk2(o[2], o[3]); w.z = pk2(o[4], o[5]); w.w = pk2(o[6], o[7]);
                *(u32x4*)(rp + (size_t)r * FF2 + ch0) = w; }
        }
    }
}

#ifndef PHM
#define PHM 0x3ff
#endif
#define IN(k) (lo <= (k) && (k) < hi)
__device__ __forceinline__ void grid_bar(unsigned* ctr, unsigned target) {
    asm volatile("s_waitcnt vmcnt(0)" ::: "memory");
    __syncthreads();
    if (threadIdx.x == 0) {
        __builtin_amdgcn_fence(__ATOMIC_RELEASE, "agent");
        asm volatile("s_waitcnt vmcnt(0)" ::: "memory");
        (void)__hip_atomic_fetch_add(ctr, 1u, __ATOMIC_RELAXED, __HIP_MEMORY_SCOPE_AGENT);
        unsigned sp = 0;
        while (__hip_atomic_load(ctr, __ATOMIC_RELAXED, __HIP_MEMORY_SCOPE_AGENT) < target) { __builtin_amdgcn_s_sleep(1); if (++sp > (1u << 26)) break; }
        __builtin_amdgcn_fence(__ATOMIC_ACQUIRE, "agent");
        asm volatile("s_waitcnt vmcnt(0)" ::: "memory");
    }
    __syncthreads();
}
#define SEAM(k) do { if (IN(k) && IN((k) + 1)) grid_bar((unsigned*)(sptr(a.ws) + WS_CTL) + 128, (unsigned)((k) - lo + 1) * gridDim.x); } while (0)
template <int L>
__device__ __forceinline__ void layer_prog(const LAS Args& a, LAS unsigned char* lds, const int lo, const int hi) {
    unsigned char* ws = sptr(a.ws);
    bf16* Wb = (bf16*)(ws + WS_W);
    bf16* H = (bf16*)(ws + WS_H); bf16* G = (bf16*)(ws + WS_G); bf16* QKV = (bf16*)(ws + WS_QKV); bf16* U = (bf16*)(ws + WS_U); bf16* HALO = (bf16*)(ws + WS_HALO);
    const int G_ = gridDim.x, c_ = blockIdx.x;
    constexpr int B0 = 10 * L;
    const float* xin = L == 0 ? sptr(a.in[I_X]) : sptr(a.out);
    if (IN(B0 + 0) && (PHM & 1)) { phase_convert(a, L, lds); phase_norm(xin, sptr(a.in[I_ATTN_NORM]) + L * DM, H); }
    SEAM(B0 + 0);
    if (IN(B0 + 1) && (PHM >> 1 & 1)) { pg8::Gemm g{H, (const bf16*)((char*)Wb + W_IN), MTOK, NIN, DM, DM}; pg8::StaticOrder S; S.init(MTOK, NIN, G_, c_);
        pg8::EpiProj E{QKV, G}; pg8::gemm_phase<pg8::EpiProj, pg8::StaticOrder, true, true>(lds, g, S, E); }
    SEAM(B0 + 1);
    if (IN(B0 + 2) && (PHM >> 2 & 1)) phase_prep(a, L, lds);
    SEAM(B0 + 2);
    if (IN(B0 + 3) && (PHM >> 3 & 1)) phase_attn(a, L, lds);
    SEAM(B0 + 3);
    if (IN(B0 + 4) && (PHM >> 4 & 1)) {
        pg8::StaticOrder S; S.init(MTOK, DM, G_, c_);
        { pg8::Gemm g{H, (const bf16*)((char*)Wb + W_PA), MTOK, DM, 256, DM}; pg8::EpiGate<0> E{G, 0, QKV}; pg8::gemm_phase<pg8::EpiGate<0>, pg8::StaticOrder, true, true>(lds, g, S, E); }
        { pg8::Gemm g{H + 256, (const bf16*)((char*)Wb + W_PB), MTOK, DM, 512, DM}; pg8::EpiGate<1> E{G, 1024, QKV}; pg8::gemm_phase<pg8::EpiGate<1>, pg8::StaticOrder, true, true>(lds, g, S, E); }
        { pg8::Gemm g{H + 768, (const bf16*)((char*)Wb + W_PC), MTOK, DM, 256, DM}; pg8::EpiGate<1> E{G, 2048, QKV}; pg8::gemm_phase<pg8::EpiGate<1>, pg8::StaticOrder, true, true>(lds, g, S, E); }
    }
    SEAM(B0 + 4);
    if (IN(B0 + 5) && (PHM >> 5 & 1)) { pg8::Gemm g{QKV, (const bf16*)((char*)Wb + W_OUT), MTOK, DM, DM, DM}; pg8::StaticOrder S; S.init(MTOK, DM, G_, c_);
        pg8::EpiResid E{xin, sptr(a.out)}; pg8::gemm_phase<pg8::EpiResid, pg8::StaticOrder, true, true>(lds, g, S, E); }
    SEAM(B0 + 5);
    if (IN(B0 + 6) && (PHM >> 6 & 1)) phase_norm(sptr(a.out), sptr(a.in[I_MLP_NORM]) + L * DM, H);
    SEAM(B0 + 6);
    if (IN(B0 + 7) && (PHM >> 7 & 1)) { pg8::Gemm g{H, (const bf16*)((char*)Wb + W_UP), MTOK, FF2, DM, DM}; pg8::StaticOrder S; S.init(MTOK, FF2, G_, c_);
        pg8::EpiUp E{U, HALO}; pg8::gemm_phase<pg8::EpiUp, pg8::StaticOrder, true, true>(lds, g, S, E); }
    SEAM(B0 + 7);
    if (IN(B0 + 8) && (PHM >> 8 & 1)) phase_conv(a, L);
    SEAM(B0 + 8);
    if (IN(B0 + 9) && (PHM >> 9 & 1)) { pg8::Gemm g{U, (const bf16*)((char*)Wb + W_DOWN), MTOK, DM, FF, FF2}; pg8::StaticOrder S; S.init(MTOK, DM, G_, c_);
        pg8::EpiResid E{sptr(a.out), sptr(a.out)}; pg8::gemm_phase<pg8::EpiResid, pg8::StaticOrder, true, true>(lds, g, S, E); }
    SEAM(B0 + 9);
}
__global__ void __launch_bounds__(512, 2) mega_fwd(Args a) {
    extern __shared__ __attribute__((aligned(16))) unsigned char lds_raw[];
    LAS unsigned char* lds = (LAS unsigned char*)lds_raw;
    const int lo = a.ph_lo, hi = a.ph_hi;
    LAS Args& la = *(LAS Args*)(lds + 132096);
    if (threadIdx.x == 0) {
#pragma unroll
        for (int i = 0; i < 24; ++i) la.in[i] = a.in[i];
        la.out = a.out; la.ws = a.ws;
#pragma unroll
        for (int i = 0; i < 32; ++i) la.inv64[i] = a.inv64[i];
#pragma unroll
        for (int i = 0; i < 16; ++i) la.inv32[i] = a.inv32[i];
        la.lam_init[0] = a.lam_init[0]; la.lam_init[1] = a.lam_init[1]; la.ph_lo = lo; la.ph_hi = hi;
    }
    __syncthreads();
    if (hi - lo > 1) cg::this_grid().sync();
    layer_prog<0>(la, lds, lo, hi);
    layer_prog<1>(la, lds, lo, hi);
}

#ifndef MK_MULTI
#define MK_MULTI 0
#endif
extern "C" void kernel_launch(void* const* d_in, const int* in_sizes, int n_in, void* d_out, int out_size, void* d_ws, size_t ws_size, hipStream_t stream) {
    static int grid = 0;
    if (grid == 0) {
        if (n_in != 24 || ws_size < WS_END) { fprintf(stderr, "kernel_launch: unexpected n_in %d / ws %zu\n", n_in, ws_size); grid = -1; return; }
        int dev = 0, cus = 0, per_cu = 0;
        (void)hipGetDevice(&dev); (void)hipDeviceGetAttribute(&cus, hipDeviceAttributeMultiprocessorCount, dev);
        if (hipFuncSetAttribute((const void*)mega_fwd, hipFuncAttributeMaxDynamicSharedMemorySize, LDS_BYTES) != hipSuccess) { fprintf(stderr, "hipFuncSetAttribute failed\n"); grid = -1; return; }
        if (hipOccupancyMaxActiveBlocksPerMultiprocessor(&per_cu, (const void*)mega_fwd, 512, LDS_BYTES) != hipSuccess || per_cu < 1) per_cu = 1;
        (void)hipGetLastError();
        grid = cus * per_cu;
        fprintf(stderr, "kernel_launch: cus %d per_cu %d grid %d\n", cus, per_cu, grid);
    }
    if (grid < 0) return;
    (void)hipMemsetAsync((char*)d_ws + WS_CTL, 0, 4096, stream);
    Args a{};
    for (int i = 0; i < 24; ++i) a.in[i] = (const float*)d_in[i];
    a.out = (float*)d_out; a.ws = (unsigned char*)d_ws;
    for (int i = 0; i < 32; ++i) a.inv64[i] = 1.0f / powf(10000.0f, (float)(2 * i) / 64.0f);
    for (int i = 0; i < 16; ++i) a.inv32[i] = 1.0f / powf(10000.0f, (float)(2 * i) / 32.0f);
    for (int i = 0; i < 2; ++i) a.lam_init[i] = (float)(0.8 - 0.6 * exp(-0.3 * (double)i));
#if MK_MULTI
    for (int ph = 0; ph < NPH; ++ph) { a.ph_lo = ph; a.ph_hi = ph + 1; hipLaunchKernelGGL(mega_fwd, dim3(grid), dim3(512), LDS_BYTES, stream, a); }
#else
    a.ph_lo = 0; a.ph_hi = NPH;
    void* args[] = {&a};
    hipError_t e = hipLaunchCooperativeKernel((const void*)mega_fwd, dim3(grid), dim3(512), args, LDS_BYTES, stream);
    if (e != hipSuccess) fprintf(stderr, "cooperative launch failed: %s (grid %d)\n", hipGetErrorString(e), grid);
#endif
}
```

```cpp
#include <hip/hip_runtime.h>
#include <hip/hip_cooperative_groups.h>
#include <cstdio>
#include <cstdint>
#include <cmath>
namespace cg = cooperative_groups;

namespace pg8 {
#define PG8_LAS __attribute__((address_space(3)))
typedef unsigned short bf16_t;
typedef short bf16x8 __attribute__((ext_vector_type(8)));
typedef float f32x4 __attribute__((ext_vector_type(4)));
typedef unsigned u32x4 __attribute__((ext_vector_type(4)));
constexpr int BM = 256, BK = 64, HALF = 128, HTB = HALF * BK * 2  , STAGE_BYTES = 8 * HTB, NXCD = 8, WGM = 8;

__host__ __device__ __forceinline__ int lds_byte(int r, int c) { const int st = (r >> 4) * 2 + (c >> 5), rr = r & 15, cc = c & 31, ob = rr * 64 + cc * 2; return st * 1024 + (ob ^ (((ob >> 9) & 1) << 5)); }
__host__ __device__ __forceinline__ void stage_rc(int b, int& R, int& C) { const int st = b / 1024, sb = b % 1024, swz = sb ^ (((sb >> 9) & 1) << 5); R = (st >> 1) * 16 + swz / 64; C = (st & 1) * 32 + (swz % 64) / 2; }
__host__ __device__ __forceinline__ int perm32(int rho) { const int n = rho >> 4, i = rho & 15; return 8 * (i >> 2) + 4 * n + (i & 3); }

struct Unit { int pm, pn; };
struct Gemm { const bf16_t* A; const bf16_t* Bt; int M, N, K, lda; };
struct StaticOrder {
    int nM, nN, nwg, G, c;
    __host__ __device__ void init(int M, int N, int G_, int c_) { nM = M / BM; nN = N / BM; nwg = nM * nN; G = G_; c = c_; }
    __host__ __device__ bool next(int i, Unit& u) const {
        const long L = (long)i * G + c; if (L >= nwg) return false;
        int wgid = (int)L; { const int q = nwg / NXCD, r = nwg % NXCD, xcd = wgid % NXCD, off = wgid / NXCD; wgid = (xcd < r ? xcd * (q + 1) : r * (q + 1) + (xcd - r) * q) + off; }
        const int nig = WGM * nN, gid = wgid / nig, fm = gid * WGM, gsz = (nM - fm) < WGM ? (nM - fm) : WGM;
        u.pm = fm + ((wgid % nig) % gsz); u.pn = (wgid % nig) / gsz; return true;
    }
    __device__ __forceinline__ void a_ready(const Unit&) const {}
    __device__ __forceinline__ void done(const Unit&) const {}
};

__device__ __forceinline__ unsigned cvt_pk_bf16(float lo, float hi) { unsigned r; asm volatile("v_cvt_pk_bf16_f32 %0, %1, %2" : "=v"(r) : "v"(lo), "v"(hi)); return r; }
__device__ __forceinline__ float bflo(unsigned w) { return __builtin_bit_cast(float, w << 16); }
__device__ __forceinline__ float bfhi(unsigned w) { return __builtin_bit_cast(float, w & 0xffff0000u); }
__device__ __forceinline__ float sigmoidf_(float v) { return __builtin_amdgcn_rcpf(1.0f + __builtin_amdgcn_exp2f(-1.44269504f * v)); }
struct EpiProj {
    static constexpr bool PERM = true, AFTER_DRAIN = false;
    bf16_t* QKV; bf16_t* G;
    __device__ __forceinline__ void operator()(const f32x4 (&acc)[2][2][4][2], const Unit& u, int wr, int wc, int fr, int fq) const {
        const int row0 = u.pm * BM + wr * 64 + fr; const bool gate = u.pn >= 9;
        bf16_t* base = gate ? G : QKV; const int ldc = gate ? 3072 : 2304; const int col0 = (gate ? (u.pn - 9) : u.pn) * BM + wc * 32 + 8 * fq;
#pragma unroll
        for (int ai = 0; ai < 2; ++ai)
#pragma unroll
            for (int m = 0; m < 4; ++m) { bf16_t* rowp = base + (size_t)(row0 + ai * HALF + m * 16) * ldc + col0;
#pragma unroll
                for (int bj = 0; bj < 2; ++bj) { f32x4 v0 = acc[ai][bj][m][0], v1 = acc[ai][bj][m][1];
                    if (gate) {
#pragma unroll
                        for (int e = 0; e < 4; ++e) { v0[e] = sigmoidf_(v0[e]); v1[e] = sigmoidf_(v1[e]); } }
                    u32x4 w; w.x = cvt_pk_bf16(v0[0], v0[1]); w.y = cvt_pk_bf16(v0[2], v0[3]); w.z = cvt_pk_bf16(v1[0], v1[1]); w.w = cvt_pk_bf16(v1[2], v1[3]);
                    *(u32x4*)(rowp + bj * HALF) = w; } }
    }
};
template <int ACCUM> struct EpiGate {
    static constexpr bool PERM = true, AFTER_DRAIN = false;
    const bf16_t* G; int gcol0; bf16_t* MG;
    __device__ __forceinline__ void operator()(const f32x4 (&acc)[2][2][4][2], const Unit& u, int wr, int wc, int fr, int fq) const {
        const int row0 = u.pm * BM + wr * 64 + fr; const int col0 = u.pn * BM + wc * 32 + 8 * fq;
#pragma unroll
        for (int ai = 0; ai < 2; ++ai)
#pragma unroll
            for (int m = 0; m < 4; ++m) { const size_t r = (size_t)(row0 + ai * HALF + m * 16);
#pragma unroll
                for (int bj = 0; bj < 2; ++bj) { f32x4 v0 = acc[ai][bj][m][0], v1 = acc[ai][bj][m][1];
                    const u32x4 g = *(const u32x4*)(G + r * 3072 + gcol0 + col0 + bj * HALF);
                    v0[0] *= bflo(g.x); v0[1] *= bfhi(g.x); v0[2] *= bflo(g.y); v0[3] *= bfhi(g.y); v1[0] *= bflo(g.z); v1[1] *= bfhi(g.z); v1[2] *= bflo(g.w); v1[3] *= bfhi(g.w);
                    bf16_t* dst = MG + r * 1024 + col0 + bj * HALF;
                    if (ACCUM) { const u32x4 p = *(const u32x4*)dst;
                        v0[0] += bflo(p.x); v0[1] += bfhi(p.x); v0[2] += bflo(p.y); v0[3] += bfhi(p.y); v1[0] += bflo(p.z); v1[1] += bfhi(p.z); v1[2] += bflo(p.w); v1[3] += bfhi(p.w); }
                    u32x4 w; w.x = cvt_pk_bf16(v0[0], v0[1]); w.y = cvt_pk_bf16(v0[2], v0[3]); w.z = cvt_pk_bf16(v1[0], v1[1]); w.w = cvt_pk_bf16(v1[2], v1[3]);
                    *(u32x4*)dst = w; }
                asm volatile("" ::: "memory"); }
    }
};
struct EpiResid {
    static constexpr bool PERM = true, AFTER_DRAIN = false;
    const float* xin; float* out;
    __device__ __forceinline__ void operator()(const f32x4 (&acc)[2][2][4][2], const Unit& u, int wr, int wc, int fr, int fq) const {
        const int row0 = u.pm * BM + wr * 64 + fr; const int col0 = u.pn * BM + wc * 32 + 8 * fq;
#pragma unroll
        for (int ai = 0; ai < 2; ++ai)
#pragma unroll
            for (int m = 0; m < 4; ++m) { const size_t off = (size_t)(row0 + ai * HALF + m * 16) * 1024 + col0;
#pragma unroll
                for (int bj = 0; bj < 2; ++bj) { const float* xi = xin + off + bj * HALF; float* o = out + off + bj * HALF;
                    const f32x4 x0 = *(const f32x4*)xi, x1 = *(const f32x4*)(xi + 4);
                    *(f32x4*)o = x0 + acc[ai][bj][m][0]; *(f32x4*)(o + 4) = x1 + acc[ai][bj][m][1]; }
                asm volatile("" ::: "memory"); }
    }
};
struct EpiUp {
    static constexpr bool PERM = true, AFTER_DRAIN = false;
    bf16_t* U; bf16_t* HALO;
    __device__ __forceinline__ void operator()(const f32x4 (&acc)[2][2][4][2], const Unit& u, int wr, int wc, int fr, int fq) const {
        const int row0 = u.pm * BM + wr * 64 + fr; const int col0 = u.pn * BM + wc * 32 + 8 * fq;
#pragma unroll
        for (int ai = 0; ai < 2; ++ai)
#pragma unroll
            for (int m = 0; m < 4; ++m) { const int row = row0 + ai * HALF + m * 16; bf16_t* rowp = U + (size_t)row * 5632 + col0;
#pragma unroll
                for (int bj = 0; bj < 2; ++bj) { const f32x4 v0 = acc[ai][bj][m][0], v1 = acc[ai][bj][m][1];
                    u32x4 w; w.x = cvt_pk_bf16(v0[0], v0[1]); w.y = cvt_pk_bf16(v0[2], v0[3]); w.z = cvt_pk_bf16(v1[0], v1[1]); w.w = cvt_pk_bf16(v1[2], v1[3]);
                    *(u32x4*)(rowp + bj * HALF) = w;
                    if (m == 3 && fr >= 14) *(u32x4*)(HALO + ((size_t)(row >> 6) * 2 + (fr - 14)) * 5632 + col0 + bj * HALF) = w; } }
    }
};

template <class Epi, class Sched, bool ALIGN_EPI = false, bool SP2 = false>
__device__ __forceinline__ void gemm_phase(PG8_LAS unsigned char* lds, const Gemm g, const Sched& S, const Epi& E) {
    int tid_ = threadIdx.x; asm volatile("" : "+v"(tid_));
    const int tid = tid_, wid = __builtin_amdgcn_readfirstlane(tid >> 6), lane = tid & 63, wr = wid >> 2, wc = wid & 3, fr = lane & 15, fq = lane >> 4;
    const int K = g.K, nt = K / BK;
    unsigned voffA[2], voffB[2];
#pragma unroll
    for (int i = 0; i < 2; ++i) { int R, C; stage_rc(tid * 16 + i * 8192, R, C); const int Rb = Epi::PERM ? ((R & ~31) + perm32(R & 31)) : R;
        voffA[i] = (unsigned)(R * g.lda + C) * 2u; voffB[i] = (unsigned)(Rb * K + C) * 2u; }
    const size_t kstep = (size_t)(BK * 2);
    const size_t hstepA = (size_t)HALF * g.lda * 2, hstepB = (size_t)HALF * K * 2;
    const size_t tstepA = 2 * hstepA, tstepB = 2 * hstepB;
    const unsigned ldsw = (unsigned)wid * 1024u;
    const int aoff = lds_byte(wr * 64 + fr, fq * 8), boff = lds_byte(wc * 32 + fr, fq * 8);
#define PG8_SA(b, h) (((b) * 2 + (h)) * HTB)
#define PG8_SB(b, h) ((4 + (b) * 2 + (h)) * HTB)
#define PG8_STAGE(bufoff, gbase, voff) do { _Pragma("unroll") for (int _i = 0; _i < 2; ++_i) \
        __builtin_amdgcn_global_load_lds((const unsigned*)((const char*)(gbase) + (voff)[_i]), (PG8_LAS unsigned*)(lds + (bufoff) + ldsw + _i * 8192), 16, 0, 0); } while (0)
#define PG8_LDA(dst, b, h) do { _Pragma("unroll") for (int m = 0; m < 4; ++m) _Pragma("unroll") for (int k = 0; k < 2; ++k) dst[m][k] = *(const PG8_LAS bf16x8*)(lds + PG8_SA(b, h) + aoff + m * 2048 + k * 1024); } while (0)
#define PG8_LDB(dst, b, h) do { _Pragma("unroll") for (int n = 0; n < 2; ++n) _Pragma("unroll") for (int k = 0; k < 2; ++k) dst[n][k] = *(const PG8_LAS bf16x8*)(lds + PG8_SB(b, h) + boff + n * 2048 + k * 1024); } while (0)
#define PG8_MMA(ai, bj, At, Bt) do { __builtin_amdgcn_s_setprio(1); _Pragma("unroll") for (int m = 0; m < 4; ++m) _Pragma("unroll") for (int n = 0; n < 2; ++n) _Pragma("unroll") for (int k = 0; k < 2; ++k) \
        acc[ai][bj][m][n] = __builtin_amdgcn_mfma_f32_16x16x32_bf16(Bt[n][k], At[m][k], acc[ai][bj][m][n], 0, 0, 0); __builtin_amdgcn_s_setprio(0); } while (0)
#define PG8_WAIT_V(n) asm volatile("s_waitcnt vmcnt(" #n ")" ::: "memory")
#define PG8_WAIT_L(n) asm volatile("s_waitcnt lgkmcnt(" #n ")" ::: "memory")
#define PG8_BAR __builtin_amdgcn_s_barrier()
#define PG8_SCHED __builtin_amdgcn_sched_barrier(0)
    Unit cur, nxt; int ui = 0;
    if (!S.next(0, cur)) return;
    f32x4 acc[2][2][4][2];
#pragma unroll
    for (int a = 0; a < 2; ++a)
#pragma unroll
        for (int b = 0; b < 2; ++b)
#pragma unroll
            for (int m = 0; m < 4; ++m)
#pragma unroll
                for (int n = 0; n < 2; ++n) acc[a][b][m][n] = (f32x4){0.f, 0.f, 0.f, 0.f};
    bf16x8 At[4][2], B0[2][2], B1[2][2];
    const char* cA = (const char*)g.A + (size_t)cur.pm * tstepA; const char* cB = (const char*)g.Bt + (size_t)cur.pn * tstepB;
    S.a_ready(cur);
    if constexpr (SP2) {
        PG8_STAGE(PG8_SB(0, 0), cB, voffB); PG8_STAGE(PG8_SB(0, 1), cB + hstepB, voffB); PG8_STAGE(PG8_SA(0, 0), cA, voffA); PG8_STAGE(PG8_SA(0, 1), cA + hstepA, voffA);
        if (wr == 1) PG8_BAR;
        PG8_WAIT_V(2); PG8_BAR;
        PG8_STAGE(PG8_SB(1, 0), cB + kstep, voffB); PG8_STAGE(PG8_SA(1, 0), cA + kstep, voffA); PG8_STAGE(PG8_SB(1, 1), cB + hstepB + kstep, voffB);
        PG8_WAIT_V(6); PG8_BAR;
    } else {
        PG8_STAGE(PG8_SB(0, 0), cB, voffB); PG8_STAGE(PG8_SA(0, 0), cA, voffA); PG8_STAGE(PG8_SB(0, 1), cB + hstepB, voffB); PG8_STAGE(PG8_SA(0, 1), cA + hstepA, voffA);
        if (wr == 1) PG8_BAR;
        PG8_WAIT_V(4); PG8_BAR;
        PG8_STAGE(PG8_SB(1, 0), cB + kstep, voffB); PG8_STAGE(PG8_SA(1, 0), cA + kstep, voffA); PG8_STAGE(PG8_SB(1, 1), cB + hstepB + kstep, voffB);
        PG8_WAIT_V(6); PG8_BAR;
    }
    for (;;) {
        const bool has_next = S.next(ui + 1, nxt);
        const char* nA = has_next ? (const char*)g.A + (size_t)nxt.pm * tstepA : cA; const char* nB = has_next ? (const char*)g.Bt + (size_t)nxt.pn * tstepB : cB;
        for (int t = 0; t < nt; t += 2) {
            const bool last = (t == nt - 2);
            const char* a1 = cA + (size_t)(t + 1) * kstep;
            const char* a2 = last ? nA : cA + (size_t)(t + 2) * kstep; const char* b2 = last ? nB : cB + (size_t)(t + 2) * kstep;
            const char* a3 = a2 + kstep; const char* b3 = b2 + kstep;
            if (last && has_next) S.a_ready(nxt);
            if constexpr (SP2) {
            PG8_LDB(B0, 0, 0); PG8_LDB(B1, 0, 1); PG8_SCHED; PG8_LDA(At, 0, 0); PG8_STAGE(PG8_SA(1, 1), a1 + hstepA, voffA);
            PG8_WAIT_V(8); PG8_WAIT_L(0); PG8_BAR; PG8_MMA(0, 0, At, B0); PG8_MMA(0, 1, At, B1); PG8_BAR; PG8_SCHED;
            PG8_LDA(At, 0, 1); PG8_STAGE(PG8_SB(0, 0), b2, voffB); PG8_STAGE(PG8_SB(0, 1), b2 + hstepB, voffB); PG8_STAGE(PG8_SA(0, 0), a2, voffA);
            PG8_WAIT_V(8); PG8_WAIT_L(0); PG8_BAR; PG8_MMA(1, 0, At, B0); PG8_MMA(1, 1, At, B1); PG8_BAR; PG8_SCHED;
            PG8_LDB(B0, 1, 0); PG8_LDB(B1, 1, 1); PG8_SCHED; PG8_LDA(At, 1, 0); PG8_STAGE(PG8_SA(0, 1), a2 + hstepA, voffA);
            PG8_WAIT_V(8); PG8_WAIT_L(0); PG8_BAR; PG8_MMA(0, 0, At, B0); PG8_MMA(0, 1, At, B1); PG8_BAR; PG8_SCHED;
            PG8_LDA(At, 1, 1); PG8_STAGE(PG8_SB(1, 0), b3, voffB); PG8_STAGE(PG8_SB(1, 1), b3 + hstepB, voffB); PG8_STAGE(PG8_SA(1, 0), a3, voffA);
            PG8_WAIT_V(8); PG8_WAIT_L(0); PG8_BAR; PG8_MMA(1, 0, At, B0); PG8_MMA(1, 1, At, B1); PG8_BAR; PG8_SCHED;
            } else {
            PG8_LDB(B0, 0, 0); PG8_SCHED; PG8_LDA(At, 0, 0); PG8_STAGE(PG8_SA(1, 1), a1 + hstepA, voffA);
            PG8_WAIT_L(8); PG8_BAR; PG8_WAIT_L(0); PG8_MMA(0, 0, At, B0); PG8_BAR; PG8_SCHED;
            PG8_LDB(B1, 0, 1); PG8_STAGE(PG8_SB(0, 0), b2, voffB);
            PG8_BAR; PG8_WAIT_L(0); PG8_MMA(0, 1, At, B1); PG8_BAR;
            PG8_LDA(At, 0, 1); PG8_STAGE(PG8_SA(0, 0), a2, voffA);
            PG8_BAR; PG8_WAIT_L(0); PG8_MMA(1, 0, At, B0); PG8_BAR; PG8_SCHED;
            PG8_STAGE(PG8_SB(0, 1), b2 + hstepB, voffB);
            PG8_WAIT_V(6); PG8_BAR; PG8_MMA(1, 1, At, B1); PG8_BAR;
            PG8_LDB(B0, 1, 0); PG8_SCHED; PG8_LDA(At, 1, 0); PG8_STAGE(PG8_SA(0, 1), a2 + hstepA, voffA);
            PG8_WAIT_L(8); PG8_BAR; PG8_WAIT_L(0); PG8_MMA(0, 0, At, B0); PG8_BAR; PG8_SCHED;
            PG8_LDB(B1, 1, 1); PG8_STAGE(PG8_SB(1, 0), b3, voffB);
            PG8_BAR; PG8_WAIT_L(0); PG8_MMA(0, 1, At, B1); PG8_BAR;
            PG8_LDA(At, 1, 1); PG8_STAGE(PG8_SA(1, 0), a3, voffA);
            PG8_BAR; PG8_WAIT_L(0); PG8_MMA(1, 0, At, B0); PG8_BAR; PG8_SCHED;
            PG8_STAGE(PG8_SB(1, 1), b3 + hstepB, voffB);
            PG8_WAIT_V(6); PG8_BAR; PG8_MMA(1, 1, At, B1); PG8_BAR;
            }
        }
        if constexpr (ALIGN_EPI) { if (wr == 0) PG8_BAR; }
        if constexpr (!Epi::AFTER_DRAIN) { E(acc, cur, wr, wc, fr, fq); S.done(cur); }
        if (!has_next) break;
#pragma unroll
        for (int a = 0; a < 2; ++a)
#pragma unroll
            for (int b = 0; b < 2; ++b)
#pragma unroll
                for (int m = 0; m < 4; ++m)
#pragma unroll
                    for (int n = 0; n < 2; ++n) acc[a][b][m][n] = (f32x4){0.f, 0.f, 0.f, 0.f};
        cur = nxt; cA = nA; cB = nB; ++ui;
        if constexpr (ALIGN_EPI) { if (wr == 1) PG8_BAR; }
    }
    PG8_WAIT_V(0);
    if constexpr (!ALIGN_EPI) { if (wr == 0) PG8_BAR; }
    PG8_BAR;
    if constexpr (Epi::AFTER_DRAIN) { E.fused(acc, cur, wr, wc, fr, fq, lds, wid, lane); S.done(cur); }
#undef PG8_SA
#undef PG8_SB
#undef PG8_STAGE
#undef PG8_LDA
#undef PG8_LDB
#undef PG8_MMA
#undef PG8_WAIT_V
#undef PG8_WAIT_L
#undef PG8_BAR
#undef PG8_SCHED
}
}

#define LAS __attribute__((address_space(3)))
typedef unsigned short bf16;
typedef short bf16x8 __attribute__((ext_vector_type(8)));
typedef float f32x4 __attribute__((ext_vector_type(4)));
typedef float f32x16 __attribute__((ext_vector_type(16)));
typedef unsigned u32x4 __attribute__((ext_vector_type(4)));
typedef unsigned u32x2 __attribute__((ext_vector_type(2)));
constexpr int SEQ = 8192, MTOK = 16384, DM = 1024, NIN = 5376, NQKV = 2304, NGATE = 3072, FF = 2816, FF2 = 5632;
constexpr size_t MiB = 1u << 20;
constexpr size_t WS_CTL = 0, WS_KMP = 64 * 1024;
constexpr size_t WS_W = 1 * MiB;
constexpr size_t W_IN = 0, W_PA = W_IN + (size_t)NIN * DM * 2, W_PB = W_PA + 1024 * 256 * 2, W_PC = W_PB + 1024 * 512 * 2, W_OUT = W_PC + 1024 * 256 * 2,
                 W_UP = W_OUT + 1024 * 1024 * 2, W_DOWN = W_UP + (size_t)FF2 * DM * 2, W_END = W_DOWN + (size_t)DM * FF * 2;
static_assert(W_END <= 31 * MiB, "weights");
constexpr size_t WS_H = 32 * MiB;
constexpr size_t WS_G = 64 * MiB;
constexpr size_t WS_QKV = 160 * MiB;
constexpr size_t WS_VT = 232 * MiB;
constexpr size_t WS_U = 64 * MiB;
constexpr size_t WS_HALO = 240 * MiB;
constexpr size_t WS_END = 252 * MiB;
constexpr int LDS_BYTES = 147456;
constexpr int NPH = 20;

struct Args {
    const float* in[24]; float* out; unsigned char* ws;
    float inv64[32]; float inv32[16]; float lam_init[2];
    int ph_lo, ph_hi;
};
enum { I_X = 0, I_ATTN_NORM, I_W_IN, I_QN_A, I_KN_A, I_QN_B, I_KN_B, I_SINKS, I_QN_C, I_KN_C, I_LQ1, I_LK1, I_LQ2, I_LK2, I_SUBLN, I_WPA, I_WPB, I_WPC, I_WOUT, I_MLP_NORM, I_WUP, I_CONVW, I_CONVB, I_WDOWN };

template <class T> __device__ __forceinline__ T* sptr(T* p) { const unsigned long long v = (unsigned long long)p;
    const unsigned lo = __builtin_amdgcn_readfirstlane((unsigned)v), hi = __builtin_amdgcn_readfirstlane((unsigned)(v >> 32)); return (T*)(((unsigned long long)hi << 32) | lo); }

__device__ __forceinline__ unsigned f2bf(float f) { unsigned u = __builtin_bit_cast(unsigned, f); return (u + 0x7fffu + ((u >> 16) & 1u)) >> 16; }
__device__ __forceinline__ unsigned pk2(float lo, float hi) { return pg8::cvt_pk_bf16(lo, hi); }
__device__ __forceinline__ float bf2f(unsigned short v) { return __builtin_bit_cast(float, (unsigned)v << 16); }
__device__ __forceinline__ float wave_sum(float v) {
#pragma unroll
    for (int o = 1; o < 64; o <<= 1) v += __shfl_xor(v, o);
    return v;
}
#define LDS_WAIT() asm volatile("s_waitcnt lgkmcnt(0)" ::: "memory")

__device__ __forceinline__ void transpose_item(const float* W, int K, int N, bf16* WT, LAS float* scr, int item, int lane) {
    const int nblk = N / 32, kb = item / nblk, nb = item % nblk, k0 = 64 * kb, n0 = 32 * nb;
#pragma unroll 8
    for (int i = 0; i < 32; ++i) { const int kk = 2 * i + (lane >> 5); scr[kk * 33 + (lane & 31)] = W[(size_t)(k0 + kk) * N + n0 + (lane & 31)]; }
    LDS_WAIT(); asm volatile("" ::: "memory");
    const int c = lane & 7;
#pragma unroll
    for (int j = 0; j < 4; ++j) { const int n = (lane >> 3) + 8 * j; const LAS float* s = scr + (8 * c) * 33 + n;
        u32x4 o; o.x = pk2(s[0 * 33], s[1 * 33]); o.y = pk2(s[2 * 33], s[3 * 33]); o.z = pk2(s[4 * 33], s[5 * 33]); o.w = pk2(s[6 * 33], s[7 * 33]);
        *(u32x4*)(WT + (size_t)(n0 + n) * K + k0 + 8 * c) = o; }
    LDS_WAIT(); asm volatile("" ::: "memory");
}
__device__ __forceinline__ void rms_row_to_bf16(const float* xrow, const float* gain, bf16* orow, int lane) {
    const f32x4* xr = (const f32x4*)xrow + lane; const f32x4* gr = (const f32x4*)gain + lane;
    f32x4 v[4]; float s = 0.f;
#pragma unroll
    for (int j = 0; j < 4; ++j) { v[j] = xr[64 * j]; s += (v[j].x * v[j].x + v[j].y * v[j].y) + (v[j].z * v[j].z + v[j].w * v[j].w); }
    const float rinv = 1.0f / sqrtf(wave_sum(s) * (1.f / DM) + 1e-6f);
    unsigned long long* o8 = (unsigned long long*)orow + lane;
#pragma unroll
    for (int j = 0; j < 4; ++j) { const f32x4 g = gr[64 * j];
        o8[64 * j] = (unsigned long long)pk2(v[j].x * rinv * g.x, v[j].y * rinv * g.y) | ((unsigned long long)pk2(v[j].z * rinv * g.z, v[j].w * rinv * g.w) << 32); }
}

__device__ __forceinline__ void phase_convert(const LAS Args& a, int layer, LAS unsigned char* lds) {
    int tid_ = threadIdx.x; asm volatile("" : "+v"(tid_));
    const int lane = tid_ & 63, wave = tid_ >> 6, gw = blockIdx.x * 8 + wave, NGW = gridDim.x * 8;
    LAS float* scr = (LAS float*)(lds + wave * 16384);
    bf16* Wb = (bf16*)(sptr(a.ws) + WS_W);
    constexpr int I0 = 16 * (NIN / 32), I1 = 4 * 32, I2 = 8 * 32, I3 = 4 * 32, I4 = 16 * 32, I5 = 16 * (FF2 / 32), I6 = (FF / 64) * 32;
    constexpr int NIT = I0 + I1 + I2 + I3 + I4 + I5 + I6;
    for (int it = gw; it < NIT; it += NGW) {
        int r = it;
        if (r < I0) { transpose_item(sptr(a.in[I_W_IN]) + (size_t)layer * DM * NIN, DM, NIN, (bf16*)((char*)Wb + W_IN), scr, r, lane); continue; } r -= I0;
        if (r < I1) { transpose_item(sptr(a.in[I_WPA]) + (size_t)layer * 256 * DM, 256, DM, (bf16*)((char*)Wb + W_PA), scr, r, lane); continue; } r -= I1;
        if (r < I2) { transpose_item(sptr(a.in[I_WPB]) + (size_t)layer * 512 * DM, 512, DM, (bf16*)((char*)Wb + W_PB), scr, r, lane); continue; } r -= I2;
        if (r < I3) { transpose_item(sptr(a.in[I_WPC]) + (size_t)layer * 256 * DM, 256, DM, (bf16*)((char*)Wb + W_PC), scr, r, lane); continue; } r -= I3;
        if (r < I4) { transpose_item(sptr(a.in[I_WOUT]) + (size_t)layer * DM * DM, DM, DM, (bf16*)((char*)Wb + W_OUT), scr, r, lane); continue; } r -= I4;
        if (r < I5) { transpose_item(sptr(a.in[I_WUP]) + (size_t)layer * DM * FF2, DM, FF2, (bf16*)((char*)Wb + W_UP), scr, r, lane); continue; } r -= I5;
        transpose_item(sptr(a.in[I_WDOWN]) + (size_t)layer * FF * DM, FF, DM, (bf16*)((char*)Wb + W_DOWN), scr, r, lane);
    }
}
__device__ __forceinline__ void phase_norm(const float* x, const float* gain, bf16* H) {
    int tid_ = threadIdx.x; asm volatile("" : "+v"(tid_));
    const int lane = tid_ & 63, wave = tid_ >> 6, gw = blockIdx.x * 8 + wave, NGW = gridDim.x * 8;
    for (int m = gw; m < MTOK; m += NGW) rms_row_to_bf16(x + (size_t)m * DM, gain, H + (size_t)m * DM, lane);
}

__device__ __forceinline__ void sincos_rev(float ang, float& s, float& c) {
    const float k = rintf(ang * 0.15915494309f);
    float r = fmaf(-k, 6.28125f, ang); r = fmaf(-k, 1.9353071795864769e-3f, r);
    const float f = r * 0.15915494309f;
    s = __builtin_amdgcn_sinf(f); c = __builtin_amdgcn_cosf(f);
}
__device__ __forceinline__ void phase_prep(const LAS Args& a, int layer, LAS unsigned char* lds) {
    int tid_ = threadIdx.x; asm volatile("" : "+v"(tid_));
    const int tid = tid_, lane = tid & 63, wave = tid >> 6;
    bf16* QKV = (bf16*)(sptr(a.ws) + WS_QKV); bf16* VT = (bf16*)(sptr(a.ws) + WS_VT); float* KMP = (float*)(sptr(a.ws) + WS_KMP);
    LAS unsigned short* vt = (LAS unsigned short*)lds;
    LAS float* kms = (LAS float*)(lds + 10 * 64 * 68 * 2);
    const float gqa = sptr(a.in[I_QN_A])[layer * 64 + lane], gka = sptr(a.in[I_KN_A])[layer * 64 + lane], gqb = sptr(a.in[I_QN_B])[layer * 64 + lane], gkb = sptr(a.in[I_KN_B])[layer * 64 + lane];
    const float gqc = sptr(a.in[I_QN_C])[layer * 32 + (lane & 31)], gkc = sptr(a.in[I_KN_C])[layer * 32 + (lane & 31)];
    const float iv64 = a.inv64[lane & 31], iv32 = a.inv32[lane & 15];
    const float sg64 = (lane & 32) ? 1.f : -1.f, sg32 = (lane & 16) ? 1.f : -1.f;
    const float QS64 = 0.125f * 1.44269504f, QS32 = 0.17677669529f * 1.44269504f;
    for (int c = blockIdx.x; c < MTOK / 64; c += gridDim.x) {
        const int tb = 64 * c, b = tb / SEQ, spos0 = tb % SEQ;
        float kacc[4] = {0.f, 0.f, 0.f, 0.f};
        for (int i = 0; i < 8; ++i) {
            const int p64 = wave * 8 + i, tok = tb + p64, pos = spos0 + p64;
            bf16* row = QKV + (size_t)tok * NQKV;
            float v[36];
#pragma unroll
            for (int s = 0; s < 36; ++s) v[s] = bf2f(row[64 * s + lane]);
            float s64, c64, s32, c32; sincos_rev((float)pos * iv64, s64, c64); sincos_rev((float)pos * iv32, s32, c32);
            s64 *= sg64; s32 *= sg32;
            const int k16 = p64 & 15, ppos = (p64 & ~15) | (8 * ((k16 >> 2) & 1) + 4 * ((k16 >> 3) & 1) + (k16 & 3));
#pragma unroll
            for (int s = 0; s < 36; ++s) {
                const bool isv = (s >= 8 && s < 12) || (s >= 22 && s < 24) || (s >= 32);
                if (isv) { const int hv = s < 12 ? s - 8 : (s < 24 ? 4 + s - 22 : 6 + s - 32); vt[(hv * 64 + lane) * 68 + ppos] = (unsigned short)f2bf(v[s]); continue; }
                const bool isc = s >= 24;
                float x = v[s], ss = x * x;
                ss += __shfl_xor(ss, 1); ss += __shfl_xor(ss, 2); ss += __shfl_xor(ss, 4); ss += __shfl_xor(ss, 8); ss += __shfl_xor(ss, 16);
                if (!isc) ss += __shfl_xor(ss, 32);
                const float rinv = 1.0f / sqrtf(ss * (isc ? (1.f / 32.f) : (1.f / 64.f)) + 1e-6f);
                float g, qs = 1.f;
                if (s < 4) { g = gqa; qs = QS64; } else if (s < 8) g = gka; else if (s < 20) { g = gqb; qs = QS64; } else if (s < 22) g = gkb; else if (s < 28) { g = gqc; qs = QS32; } else g = gkc;
                x = x * rinv * g;
                const float partner = __shfl_xor(x, isc ? 16 : 32);
                const float y = isc ? (x * c32 + partner * s32) : (x * c64 + partner * s64);
                if (s >= 4 && s < 8) kacc[s - 4] += y;
                row[64 * s + lane] = (unsigned short)f2bf(y * qs);
            }
        }
#pragma unroll
        for (int h = 0; h < 4; ++h) kms[(wave * 4 + h) * 64 + lane] = kacc[h];
        __syncthreads();
        if (tid < 256) { float s = 0.f;
#pragma unroll
            for (int w = 0; w < 8; ++w) s += kms[w * 256 + tid];
            KMP[(size_t)c * 256 + tid] = s; }
#pragma unroll
        for (int j = 0; j < 10; ++j) { const int idx = tid + 512 * j, r = idx >> 3, ch = idx & 7, hv = r >> 6, dv = r & 63;
            const LAS u32x2* src = (const LAS u32x2*)(lds + (size_t)r * 136 + ch * 16);
            const u32x2 lo = src[0], hi = src[1]; u32x4 o; o.x = lo.x; o.y = lo.y; o.z = hi.x; o.w = hi.y;
            *(u32x4*)(VT + (((size_t)b * 10 + hv) * 64 + dv) * SEQ + spos0 + 8 * ch) = o; }
        __syncthreads();
    }
}

#ifndef ATM
#define ATM 7
#endif
#define MFMA32(a, b, c) __builtin_amdgcn_mfma_f32_32x32x16_bf16((a), (b), (c), 0, 0, 0)
__device__ __forceinline__ bf16x8 pack8(float p0, float p1, float p2, float p3, float p4, float p5, float p6, float p7) {
    u32x4 p;
    asm volatile("v_cvt_pk_bf16_f32 %0, %4, %5\n\tv_cvt_pk_bf16_f32 %1, %6, %7\n\tv_cvt_pk_bf16_f32 %2, %8, %9\n\tv_cvt_pk_bf16_f32 %3, %10, %11\n\ts_nop 1"
                 : "=&v"(p[0]), "=&v"(p[1]), "=&v"(p[2]), "=&v"(p[3]) : "v"(p0), "v"(p1), "v"(p2), "v"(p3), "v"(p4), "v"(p5), "v"(p6), "v"(p7));
    return __builtin_bit_cast(bf16x8, p);
}
constexpr int AT_K = 0, AT_V = 18432, AT_KM = 36864, AT_MISC = 45056;
constexpr int NUNITS = 1024;

template <int MODE>
__device__ __forceinline__ void attn_unit(const LAS Args& a, int layer, LAS unsigned char* lds, int b, int head, int qt) {
    int tid_ = threadIdx.x; asm volatile("" : "+v"(tid_));
    const int tid = tid_, lane = tid & 63, wave = __builtin_amdgcn_readfirstlane(tid >> 6), qrow = lane & 31, hh = lane >> 5;
    const int q0 = qt * 256, q0w = q0 + wave * 32, qpos = q0w + qrow;
    const size_t tok = (size_t)b * SEQ + qpos;
    const bf16* QKV = (const bf16*)(sptr(a.ws) + WS_QKV); const bf16* VT = (const bf16*)(sptr(a.ws) + WS_VT); bf16* Y = (bf16*)(sptr(a.ws) + WS_H);
    const int qcol = MODE == 0 ? head * 64 : (MODE == 1 ? 768 + head * 64 : 1536 + head * 64);
    const int kcol = MODE == 0 ? 256 + head * 64 : (MODE == 1 ? 1280 + (head >> 2) * 64 : 1792 + head * 64);
    const int hv = MODE == 0 ? head : (MODE == 1 ? 4 + (head >> 2) : 6 + head);
    const int ycol = MODE == 0 ? head * 64 : (MODE == 1 ? 256 + head * 64 : 768 + head * 64);
    volatile LAS unsigned* misc = (volatile LAS unsigned*)(lds + AT_MISC);
    bf16x8 qf[4];
#pragma unroll
    for (int i = 0; i < 4; ++i) qf[i] = *(const bf16x8*)(QKV + tok * NQKV + qcol + 16 * i + 8 * hh);
    unsigned mymask = 0u, umask = 0u;
    if (MODE == 0) {
        if (qt <= 3) { mymask = (1u << qt) - 1u; umask = mymask; }
        else {
            LAS float* kml = (LAS float*)(lds + AT_KM);
            const float* KMP = (const float*)(sptr(a.ws) + WS_KMP);
            for (int idx = tid; idx < qt * 64; idx += 512) { const int j = idx >> 6, d = idx & 63; const float* p = KMP + ((size_t)(b * 128 + 4 * j) * 4 + head) * 64 + d;
                kml[idx] = (p[0] + p[256] + p[512] + p[768]) * (1.f / 256.f); }
            if (tid == 0) misc[2] = 0u;
            __syncthreads();
            float qv[32];
#pragma unroll
            for (int i = 0; i < 4; ++i) { const u32x4 w = *(const u32x4*)(QKV + tok * NQKV + qcol + 32 * hh + 8 * i);
                qv[8 * i + 0] = pg8::bflo(w.x); qv[8 * i + 1] = pg8::bfhi(w.x); qv[8 * i + 2] = pg8::bflo(w.y); qv[8 * i + 3] = pg8::bfhi(w.y);
                qv[8 * i + 4] = pg8::bflo(w.z); qv[8 * i + 5] = pg8::bfhi(w.z); qv[8 * i + 6] = pg8::bflo(w.w); qv[8 * i + 7] = pg8::bfhi(w.w); }
            float v0 = -INFINITY, v1 = -INFINITY, v2 = -INFINITY; int i0 = 0, i1 = 0, i2 = 0;
            for (int j = 0; j < qt; ++j) {
                const LAS f32x4* kr = (const LAS f32x4*)(kml + j * 64 + 32 * hh);
                float acc = 0.f;
#pragma unroll
                for (int i = 0; i < 8; ++i) { const f32x4 kk = kr[i]; acc += qv[4 * i] * kk.x + qv[4 * i + 1] * kk.y + qv[4 * i + 2] * kk.z + qv[4 * i + 3] * kk.w; }
                const float g = acc + __shfl_xor(acc, 32);
                if (g > v0) { v2 = v1; i2 = i1; v1 = v0; i1 = i0; v0 = g; i0 = j; }
                else if (g > v1) { v2 = v1; i2 = i1; v1 = g; i1 = j; }
                else if (g > v2) { v2 = g; i2 = j; }
            }
            mymask = (1u << i0) | (1u << i1) | (1u << i2);
            atomicOr((unsigned*)(lds + AT_MISC) + 2, mymask);
            __syncthreads();
            umask = misc[2];
        }
    }
    float lam = 0.f, sinkv = 0.f;
    if (MODE == 2) { float t1 = 0.f, t2 = 0.f;
        if (lane < 32) { t1 = sptr(a.in[I_LQ1])[layer * 32 + lane] * sptr(a.in[I_LK1])[layer * 32 + lane]; t2 = sptr(a.in[I_LQ2])[layer * 32 + lane] * sptr(a.in[I_LK2])[layer * 32 + lane]; }
        lam = expf(wave_sum(t1)) - expf(wave_sum(t2)) + a.lam_init[layer]; }
    if (MODE == 1) sinkv = __builtin_amdgcn_exp2f(sptr(a.in[I_SINKS])[layer * 8 + head] * 1.44269504f);

    const int kt_hi = 4 * (qt + 1);
    int kt = 0;
    if (MODE == 1) kt = q0 >= 128 ? (q0 - 128) / 64 : 0;
#define VALID_TILE(t) (MODE != 0 || ((t) >> 2) == qt || ((umask >> ((t) >> 2)) & 1u))
    while (!VALID_TILE(kt)) ++kt;
    const int lrow = tid >> 3, lch = tid & 7;
    const bf16* kg = QKV + ((size_t)b * SEQ + lrow) * NQKV + kcol + 8 * lch;
    const bf16* vg = VT + (((size_t)b * 10 + hv) * 64 + lrow) * SEQ + 8 * lch;
    const int st_off = lrow * 144 + lch * 16;
    u32x4 kreg = *(const u32x4*)(kg + (size_t)(kt * 64) * NQKV), vreg = *(const u32x4*)(vg + kt * 64);
    *(LAS u32x4*)(lds + AT_K + st_off) = kreg; *(LAS u32x4*)(lds + AT_V + st_off) = vreg;
    __syncthreads();
    f32x16 o1[2], o2[2]; float l1 = 0.f, l2 = 0.f;
#pragma unroll
    for (int d = 0; d < 2; ++d)
#pragma unroll
        for (int i = 0; i < 16; ++i) { o1[d][i] = 0.f; o2[d][i] = 0.f; }
    int buf = 0;
    while (kt < kt_hi) {
        int nkt = kt + 1;
        while (nkt < kt_hi && !VALID_TILE(nkt)) ++nkt;
        const bool has_next = nkt < kt_hi;
        if (has_next) { kreg = *(const u32x4*)(kg + (size_t)(nkt * 64) * NQKV); vreg = *(const u32x4*)(vg + nkt * 64); }
#pragma unroll 1
        for (int sub = 0; sub < 2; ++sub) {
            const int k0s = kt * 64 + 32 * sub;
            bool skip, needmask = false, past = false; unsigned uwin = 0x7fffffffu; bool bit = true;
            if (MODE == 1) { skip = (k0s > q0w + 31) || (k0s + 31 + 127 < q0w); needmask = !((k0s + 31 <= q0w) && (k0s + 127 >= q0w + 31)); uwin = 128u; }
            else if (MODE == 0 && (kt >> 2) != qt) { past = true; bit = (mymask >> (kt >> 2)) & 1u; skip = (__ballot(bit) == 0ull); }
            else { skip = k0s > q0w + 31; needmask = k0s + 31 > q0w; }
            if (skip) continue;
            f32x16 S1, S2;
#pragma unroll
            for (int i = 0; i < 16; ++i) { S1[i] = 0.f; S2[i] = 0.f; }
            const LAS unsigned char* kb = lds + AT_K + buf * 9216 + (32 * sub + qrow) * 144 + hh * 16;
#pragma unroll
            for (int i = 0; i < 4; ++i) { const bf16x8 kf = *(const LAS bf16x8*)(kb + i * 32);
                if (MODE == 2 && i >= 2) S2 = MFMA32(kf, qf[i], S2); else S1 = MFMA32(kf, qf[i], S1); }
            const int dbase = qpos - k0s - 4 * hh;
            float p1[16], p2[16];
#pragma unroll
            for (int i = 0; i < 16; ++i) {
                const int ci = (i & 3) + 8 * (i >> 2);
                float e1 = __builtin_amdgcn_exp2f(S1[i]), e2 = 0.f;
                if (MODE == 2) e2 = __builtin_amdgcn_exp2f(S2[i]);
                if (needmask) { const bool ok = (unsigned)(dbase - ci) < uwin; e1 = ok ? e1 : 0.f; e2 = ok ? e2 : 0.f; }
                if (past) e1 = bit ? e1 : 0.f;
                l1 += e1; p1[i] = e1;
                if (MODE == 2) { l2 += e2; p2[i] = e2; }
            }
            bf16x8 pf1[2], pf2[2];
#pragma unroll
            for (int s = 0; s < 2; ++s) { pf1[s] = pack8(p1[8 * s], p1[8 * s + 1], p1[8 * s + 2], p1[8 * s + 3], p1[8 * s + 4], p1[8 * s + 5], p1[8 * s + 6], p1[8 * s + 7]);
                if (MODE == 2) pf2[s] = pack8(p2[8 * s], p2[8 * s + 1], p2[8 * s + 2], p2[8 * s + 3], p2[8 * s + 4], p2[8 * s + 5], p2[8 * s + 6], p2[8 * s + 7]); }
            const LAS unsigned char* vb = lds + AT_V + buf * 9216 + qrow * 144 + (32 * sub + 8 * hh) * 2;
#pragma unroll
            for (int d = 0; d < 2; ++d)
#pragma unroll
                for (int s = 0; s < 2; ++s) { const bf16x8 vf = *(const LAS bf16x8*)(vb + d * (32 * 144) + s * 32);
                    o1[d] = MFMA32(vf, pf1[s], o1[d]);
                    if (MODE == 2) o2[d] = MFMA32(vf, pf2[s], o2[d]); }
        }
        if (has_next) { *(LAS u32x4*)(lds + AT_K + (buf ^ 1) * 9216 + st_off) = kreg; *(LAS u32x4*)(lds + AT_V + (buf ^ 1) * 9216 + st_off) = vreg; }
        __syncthreads();
        buf ^= 1; kt = nkt;
    }
#undef VALID_TILE
    l1 += __shfl_xor(l1, 32);
    if (MODE == 1) l1 += sinkv;
    const float inv1 = 1.0f / l1;
    bf16* yrow = Y + tok * DM + ycol + 4 * hh;
    if (MODE != 2) {
#pragma unroll
        for (int d = 0; d < 2; ++d)
#pragma unroll
            for (int g = 0; g < 4; ++g) { u32x2 w; w.x = pk2(o1[d][4 * g] * inv1, o1[d][4 * g + 1] * inv1); w.y = pk2(o1[d][4 * g + 2] * inv1, o1[d][4 * g + 3] * inv1);
                *(u32x2*)(yrow + 32 * d + 8 * g) = w; }
    } else {
        l2 += __shfl_xor(l2, 32);
        const float c2 = lam / l2; float ss = 0.f;
#pragma unroll
        for (int d = 0; d < 2; ++d)
#pragma unroll
            for (int i = 0; i < 16; ++i) { const float o = o1[d][i] * inv1 - o2[d][i] * c2; o1[d][i] = o; ss += o * o; }
        ss += __shfl_xor(ss, 32);
        const float r = (1.0f - a.lam_init[layer]) / sqrtf(ss * (1.f / 64.f) + 1e-6f);
        const float* sg = sptr(a.in[I_SUBLN]) + layer * 64 + 4 * hh;
#pragma unroll
        for (int d = 0; d < 2; ++d)
#pragma unroll
            for (int g = 0; g < 4; ++g) { const f32x4 gg = *(const f32x4*)(sg + 32 * d + 8 * g);
                u32x2 w; w.x = pk2(o1[d][4 * g] * r * gg.x, o1[d][4 * g + 1] * r * gg.y); w.y = pk2(o1[d][4 * g + 2] * r * gg.z, o1[d][4 * g + 3] * r * gg.w);
                *(u32x2*)(yrow + 32 * d + 8 * g) = w; }
    }
}
__device__ __forceinline__ void phase_attn(const LAS Args& a, int layer, LAS unsigned char* lds, int qoff = 0) {
    unsigned* queue = (unsigned*)(sptr(a.ws) + WS_CTL) + 64 * layer + qoff;
    volatile LAS unsigned* misc = (volatile LAS unsigned*)(lds + AT_MISC);
    for (;;) {
        if (threadIdx.x == 0) misc[0] = atomicAdd(queue, 1u);
        __syncthreads();
        const unsigned u = misc[0];
        __syncthreads();
        if (u >= (unsigned)NUNITS) break;
        if (u < 512u) { const int qt = 31 - (int)(u >> 4), r = u & 15, bh = r & 7;
            if (r < 8) { if (ATM & 4) attn_unit<2>(a, layer, lds, bh >> 2, bh & 3, qt); } else { if (ATM & 1) attn_unit<0>(a, layer, lds, bh >> 2, bh & 3, qt); } }
        else { const int v = (int)u - 512, qt = 31 - (v >> 4), r = v & 15; if (ATM & 2) attn_unit<1>(a, layer, lds, r >> 3, r & 7, qt); }
    }
}

__device__ __forceinline__ void unpack8(const u32x4 w, float (&f)[8]) {
    f[0] = pg8::bflo(w.x); f[1] = pg8::bfhi(w.x); f[2] = pg8::bflo(w.y); f[3] = pg8::bfhi(w.y); f[4] = pg8::bflo(w.z); f[5] = pg8::bfhi(w.z); f[6] = pg8::bflo(w.w); f[7] = pg8::bfhi(w.w);
}
__device__ __forceinline__ void phase_conv(const LAS Args& a, int layer) {
    int tid_ = threadIdx.x; asm volatile("" : "+v"(tid_));
    const int tid = tid_;
    if (tid >= FF / 8) return;
    bf16* U = (bf16*)(sptr(a.ws) + WS_U); const bf16* HALO = (const bf16*)(sptr(a.ws) + WS_HALO);
    const int ch0 = tid * 8;
    const float* cw = sptr(a.in[I_CONVW]) + (size_t)layer * 3 * FF2; const float* cb = sptr(a.in[I_CONVB]) + (size_t)layer * FF2;
    float wg[3][8], wv[3][8], bg[8], bv[8];
#pragma unroll
    for (int e = 0; e < 8; ++e) {
#pragma unroll
        for (int j = 0; j < 3; ++j) { wg[j][e] = cw[j * FF2 + ch0 + e]; wv[j][e] = cw[j * FF2 + FF + ch0 + e]; }
        bg[e] = cb[ch0 + e]; bv[e] = cb[FF + ch0 + e]; }
    for (int c = blockIdx.x; c < MTOK / 64; c += gridDim.x) {
        float g2[8], g1[8], v2[8], v1[8];
        if ((c * 64) % SEQ == 0) {
#pragma unroll
            for (int e = 0; e < 8; ++e) { g2[e] = 0.f; g1[e] = 0.f; v2[e] = 0.f; v1[e] = 0.f; }
        } else { const bf16* hp = HALO + (size_t)(c - 1) * 2 * FF2;
            unpack8(*(const u32x4*)(hp + ch0), g2); unpack8(*(const u32x4*)(hp + FF + ch0), v2);
            unpack8(*(const u32x4*)(hp + FF2 + ch0), g1); unpack8(*(const u32x4*)(hp + FF2 + FF + ch0), v1); }
        for (int rg = 0; rg < 16; ++rg) {
            bf16* rp = U + (size_t)(c * 64 + rg * 4) * FF2;
            u32x4 gw[4], vw[4];
#pragma unroll
            for (int r = 0; r < 4; ++r) { gw[r] = *(const u32x4*)(rp + (size_t)r * FF2 + ch0); vw[r] = *(const u32x4*)(rp + (size_t)r * FF2 + FF + ch0); }
#pragma unroll
            for (int r = 0; r < 4; ++r) {
                float g0[8], v0[8], o[8]; unpack8(gw[r], g0); unpack8(vw[r], v0);
#pragma unroll
                for (int e = 0; e < 8; ++e) {
                    const float yg = bg[e] + wg[0][e] * g2[e] + wg[1][e] * g1[e] + wg[2][e] * g0[e];
                    const float yv = bv[e] + wv[0][e] * v2[e] + wv[1][e] * v1[e] + wv[2][e] * v0[e];
                    o[e] = yg * pg8::sigmoidf_(yg) * yv;
                    g2[e] = g1[e]; g1[e] = g0[e]; v2[e] = v1[e]; v1[e] = v0[e]; }
                u32x4 w; w.x = pk2(o[0], o[1]); w.y = pk2(o[2], o[3]); w.z = pk2(o[4], o[5]); w.w = pk2(o[6], o[7]);
                *(u32x4*)(rp + (size_t)r * FF2 + ch0) = w; }
        }
    }
}

#ifndef PHM
#define PHM 0x3ff
#endif
#ifndef REPM
#define REPM 0
#endif
#define IN(k) (lo <= (k) && (k) < hi)
#define XB_TMO      128
#define XB_XCNT(j)  (256  + 64 * (j))
#define XB_XSUB(j)  (1280 + 64 * (j))
#define XB_XGEN(j)  (2304 + 64 * (j))
#define XB_TOP      3328
#define XB_TOPGEN   3392
#define XCD_BAR_WORDS 3456
#define XB_SPIN_CAP (1u << 18)

__device__ __forceinline__ unsigned xb_ld(unsigned* p)              { return __hip_atomic_load(p, __ATOMIC_RELAXED, __HIP_MEMORY_SCOPE_AGENT); }
__device__ __forceinline__ unsigned xb_add(unsigned* p, unsigned v) { return __hip_atomic_fetch_add(p, v, __ATOMIC_RELAXED, __HIP_MEMORY_SCOPE_AGENT); }
__device__ __forceinline__ unsigned xb_xcc_id() { return (unsigned)__builtin_amdgcn_s_getreg((3 << 11) | 20) & 0xFu; }
#define XB_SPIN(cond, bar) do { unsigned _sp = 0; while (cond) { __builtin_amdgcn_s_sleep(1); \
    if ((++_sp & 255u) == 0u) { if (xb_ld(&(bar)[XB_TMO])) break; if (_sp > XB_SPIN_CAP) { atomicAdd(&(bar)[XB_TMO], 1u); break; } } } } while (0)

struct XcdBarrier {
    unsigned* bar; unsigned x;
    volatile LAS unsigned* st;
};

__device__ __forceinline__ XcdBarrier xcd_barrier_post(unsigned* bar, volatile LAS unsigned* st) {
    XcdBarrier b; b.bar = bar; b.x = xb_xcc_id(); b.st = st;
    if (threadIdx.x == 0) (void)xb_add(&bar[XB_XCNT(b.x)], 1u);
    return b;
}
__device__ __forceinline__ void xcd_barrier_complete(unsigned* bar, unsigned x, unsigned& nloc, unsigned& nx) {
    const unsigned G = gridDim.x * gridDim.y * gridDim.z;
    unsigned sum, cnt, mine, sp = 0u;
    for (;;) {
        sum = 0u; cnt = 0u; mine = 0u;
#pragma unroll
        for (unsigned j = 0; j < 16; ++j) { const unsigned c = xb_ld(&bar[XB_XCNT(j)]); sum += c; cnt += (c > 0u) ? 1u : 0u; mine = (j == x) ? c : mine; }
        if (sum == G) break;
        __builtin_amdgcn_s_sleep(1);
        if ((++sp & 255u) == 0u) { if (xb_ld(&bar[XB_TMO])) break; if (sp > XB_SPIN_CAP) { atomicAdd(&bar[XB_TMO], 1u); break; } }
    }
    nloc = mine > 0u ? mine : 1u; nx = cnt > 0u ? cnt : 1u;
}

__device__ __forceinline__ void xcd_barrier(const XcdBarrier& b) {
    asm volatile("s_waitcnt vmcnt(0)" ::: "memory");
    __syncthreads();
    if (threadIdx.x == 0) {
        unsigned* bar = b.bar;
        __builtin_amdgcn_s_waitcnt(0);
        unsigned nloc = b.st[0], nx = b.st[1];
        if (nloc == 0u) { xcd_barrier_complete(bar, b.x, nloc, nx); b.st[0] = nloc; b.st[1] = nx; }
        const unsigned old = xb_add(&bar[XB_XSUB(b.x)], 1u);
        const unsigned gen = old / nloc;
        if (old + 1u == (gen + 1u) * nloc) {
            __builtin_amdgcn_fence(__ATOMIC_RELEASE, "agent");
            asm volatile("s_waitcnt vmcnt(0)" ::: "memory");
            const unsigned og = xb_add(&bar[XB_TOP], 1u);
            const unsigned tg = og / nx;
            if (og + 1u == (tg + 1u) * nx) xb_add(&bar[XB_TOPGEN], 1u);
            else XB_SPIN(xb_ld(&bar[XB_TOPGEN]) == tg, bar);
            __builtin_amdgcn_fence(__ATOMIC_ACQUIRE, "agent");
            xb_add(&bar[XB_XGEN(b.x)], 1u);
            asm volatile("s_waitcnt vmcnt(0)" ::: "memory");
        } else {
            XB_SPIN(xb_ld(&bar[XB_XGEN(b.x)]) == gen, bar);
            __builtin_amdgcn_fence(__ATOMIC_ACQUIRE, "agent");
            asm volatile("s_waitcnt vmcnt(0)" ::: "memory");
        }
    }
    __syncthreads();
}


#define SEAM(k) do { if (IN(k) && IN((k) + 1)) xcd_barrier(xbar); } while (0)
template <int L>
__device__ __forceinline__ void layer_prog(const LAS Args& a, LAS unsigned char* lds, const XcdBarrier& xbar, const int lo, const int hi) {
    unsigned char* ws = sptr(a.ws);
    bf16* Wb = (bf16*)(ws + WS_W);
    bf16* H = (bf16*)(ws + WS_H); bf16* G = (bf16*)(ws + WS_G); bf16* QKV = (bf16*)(ws + WS_QKV); bf16* U = (bf16*)(ws + WS_U); bf16* HALO = (bf16*)(ws + WS_HALO);
    const int G_ = gridDim.x, c_ = blockIdx.x;
    constexpr int B0 = 10 * L;
    const float* xin = L == 0 ? sptr(a.in[I_X]) : sptr(a.out);
    if (IN(B0 + 0) && (PHM & 1)) for (int rep = 0; rep < 1 + (REPM & 1); ++rep) { phase_convert(a, L, lds); phase_norm(xin, sptr(a.in[I_ATTN_NORM]) + L * DM, H); }
    SEAM(B0 + 0);
    if (IN(B0 + 1) && (PHM >> 1 & 1)) for (int rep = 0; rep < 1 + (REPM >> 1 & 1); ++rep) { pg8::Gemm g{H, (const bf16*)((char*)Wb + W_IN), MTOK, NIN, DM, DM}; pg8::StaticOrder S; S.init(MTOK, NIN, G_, c_);
        pg8::EpiProj E{QKV, G}; pg8::gemm_phase<pg8::EpiProj, pg8::StaticOrder, true, true>(lds, g, S, E); }
    SEAM(B0 + 1);
    if (IN(B0 + 2) && (PHM >> 2 & 1)) phase_prep(a, L, lds);
    SEAM(B0 + 2);
    if (IN(B0 + 3) && (PHM >> 3 & 1)) { phase_attn(a, L, lds); if (REPM >> 3 & 1) phase_attn(a, L, lds, 32); }
    SEAM(B0 + 3);
    if (IN(B0 + 4) && (PHM >> 4 & 1)) for (int rep = 0; rep < 1 + (REPM >> 4 & 1); ++rep) {
        pg8::StaticOrder S; S.init(MTOK, DM, G_, c_);
        { pg8::Gemm g{H, (const bf16*)((char*)Wb + W_PA), MTOK, DM, 256, DM}; pg8::EpiGate<0> E{G, 0, QKV}; pg8::gemm_phase<pg8::EpiGate<0>, pg8::StaticOrder, true, true>(lds, g, S, E); }
        { pg8::Gemm g{H + 256, (const bf16*)((char*)Wb + W_PB), MTOK, DM, 512, DM}; pg8::EpiGate<1> E{G, 1024, QKV}; pg8::gemm_phase<pg8::EpiGate<1>, pg8::StaticOrder, true, true>(lds, g, S, E); }
        { pg8::Gemm g{H + 768, (const bf16*)((char*)Wb + W_PC), MTOK, DM, 256, DM}; pg8::EpiGate<1> E{G, 2048, QKV}; pg8::gemm_phase<pg8::EpiGate<1>, pg8::StaticOrder, true, true>(lds, g, S, E); }
    }
    SEAM(B0 + 4);
    if (IN(B0 + 5) && (PHM >> 5 & 1)) { pg8::Gemm g{QKV, (const bf16*)((char*)Wb + W_OUT), MTOK, DM, DM, DM}; pg8::StaticOrder S; S.init(MTOK, DM, G_, c_);
        pg8::EpiResid E{xin, sptr(a.out)}; pg8::gemm_phase<pg8::EpiResid, pg8::StaticOrder, true, true>(lds, g, S, E); }
    SEAM(B0 + 5);
    if (IN(B0 + 6) && (PHM >> 6 & 1)) for (int rep = 0; rep < 1 + (REPM >> 6 & 1); ++rep) phase_norm(sptr(a.out), sptr(a.in[I_MLP_NORM]) + L * DM, H);
    SEAM(B0 + 6);
    if (IN(B0 + 7) && (PHM >> 7 & 1)) for (int rep = 0; rep < 1 + (REPM >> 7 & 1); ++rep) { pg8::Gemm g{H, (const bf16*)((char*)Wb + W_UP), MTOK, FF2, DM, DM}; pg8::StaticOrder S; S.init(MTOK, FF2, G_, c_);
        pg8::EpiUp E{U, HALO}; pg8::gemm_phase<pg8::EpiUp, pg8::StaticOrder, true, true>(lds, g, S, E); }
    SEAM(B0 + 7);
    if (IN(B0 + 8) && (PHM >> 8 & 1)) phase_conv(a, L);
    SEAM(B0 + 8);
    if (IN(B0 + 9) && (PHM >> 9 & 1)) { pg8::Gemm g{U, (const bf16*)((char*)Wb + W_DOWN), MTOK, DM, FF, FF2}; pg8::StaticOrder S; S.init(MTOK, DM, G_, c_);
        pg8::EpiResid E{sptr(a.out), sptr(a.out)}; pg8::gemm_phase<pg8::EpiResid, pg8::StaticOrder, true, true>(lds, g, S, E); }
    SEAM(B0 + 9);
}
__global__ void __launch_bounds__(512, 2) mega_fwd(Args a) {
    extern __shared__ __attribute__((aligned(16))) unsigned char lds_raw[];
    LAS unsigned char* lds = (LAS unsigned char*)lds_raw;
    const int lo = a.ph_lo, hi = a.ph_hi;
    LAS Args& la = *(LAS Args*)(lds + 132096);
    if (threadIdx.x == 0) {
#pragma unroll
        for (int i = 0; i < 24; ++i) la.in[i] = a.in[i];
        la.out = a.out; la.ws = a.ws;
#pragma unroll
        for (int i = 0; i < 32; ++i) la.inv64[i] = a.inv64[i];
#pragma unroll
        for (int i = 0; i < 16; ++i) la.inv32[i] = a.inv32[i];
        la.lam_init[0] = a.lam_init[0]; la.lam_init[1] = a.lam_init[1]; la.ph_lo = lo; la.ph_hi = hi;
        ((LAS unsigned*)(lds + 132096 + 512))[0] = 0u; ((LAS unsigned*)(lds + 132096 + 512))[1] = 0u;
    }
    __syncthreads();
    if (hi - lo > 1) cg::this_grid().sync();
    XcdBarrier xbar; xbar.bar = (unsigned*)(a.ws + WS_CTL) + 1024; xbar.x = 0; xbar.st = nullptr;
    if (hi - lo > 1) xbar = xcd_barrier_post((unsigned*)(a.ws + WS_CTL) + 1024, (volatile LAS unsigned*)(lds + 132096 + 512));
    layer_prog<0>(la, lds, xbar, lo, hi);
    layer_prog<1>(la, lds, xbar, lo, hi);
}

#ifndef MK_MULTI
#define MK_MULTI 0
#endif
extern "C" void kernel_launch(void* const* d_in, const int* in_sizes, int n_in, void* d_out, int out_size, void* d_ws, size_t ws_size, hipStream_t stream) {
    static int grid = 0;
    if (grid == 0) {
        if (n_in != 24 || ws_size < WS_END) { fprintf(stderr, "kernel_launch: unexpected n_in %d / ws %zu\n", n_in, ws_size); grid = -1; return; }
        int dev = 0, cus = 0, per_cu = 0;
        (void)hipGetDevice(&dev); (void)hipDeviceGetAttribute(&cus, hipDeviceAttributeMultiprocessorCount, dev);
        if (hipFuncSetAttribute((const void*)mega_fwd, hipFuncAttributeMaxDynamicSharedMemorySize, LDS_BYTES) != hipSuccess) { fprintf(stderr, "hipFuncSetAttribute failed\n"); grid = -1; return; }
        if (hipOccupancyMaxActiveBlocksPerMultiprocessor(&per_cu, (const void*)mega_fwd, 512, LDS_BYTES) != hipSuccess || per_cu < 1) per_cu = 1;
        (void)hipGetLastError();
        grid = cus * per_cu;
        fprintf(stderr, "kernel_launch: cus %d per_cu %d grid %d\n", cus, per_cu, grid);
    }
    if (grid < 0) return;
    (void)hipMemsetAsync((char*)d_ws + WS_CTL, 0, 32768, stream);
    Args a{};
    for (int i = 0; i < 24; ++i) a.in[i] = (const float*)d_in[i];
    a.out = (float*)d_out; a.ws = (unsigned char*)d_ws;
    for (int i = 0; i < 32; ++i) a.inv64[i] = 1.0f / powf(10000.0f, (float)(2 * i) / 64.0f);
    for (int i = 0; i < 16; ++i) a.inv32[i] = 1.0f / powf(10000.0f, (float)(2 * i) / 32.0f);
    for (int i = 0; i < 2; ++i) a.lam_init[i] = (float)(0.8 - 0.6 * exp(-0.3 * (double)i));
#if MK_MULTI
    for (int ph = 0; ph < NPH; ++ph) { a.ph_lo = ph; a.ph_hi = ph + 1; hipLaunchKernelGGL(mega_fwd, dim3(grid), dim3(512), LDS_BYTES, stream, a); }
#else
    a.ph_lo = 0; a.ph_hi = NPH;
    void* args[] = {&a};
    hipError_t e = hipLaunchCooperativeKernel((const void*)mega_fwd, dim3(grid), dim3(512), args, LDS_BYTES, stream);
    if (e != hipSuccess) fprintf(stderr, "cooperative launch failed: %s (grid %d)\n", hipGetErrorString(e), grid);
#endif
}
```

```cpp
#include <hip/hip_runtime.h>
#include <hip/hip_cooperative_groups.h>
#include <cstdio>
#include <cstdint>
#include <cmath>
namespace cg = cooperative_groups;

namespace pg8 {
#define PG8_LAS __attribute__((address_space(3)))
typedef unsigned short bf16_t;
typedef short bf16x8 __attribute__((ext_vector_type(8)));
typedef float f32x4 __attribute__((ext_vector_type(4)));
typedef unsigned u32x4 __attribute__((ext_vector_type(4)));
constexpr int BM = 256, BK = 64, HALF = 128, HTB = HALF * BK * 2  , STAGE_BYTES = 8 * HTB, NXCD = 8, WGM = 8;

__host__ __device__ __forceinline__ int lds_byte(int r, int c) { const int st = (r >> 4) * 2 + (c >> 5), rr = r & 15, cc = c & 31, ob = rr * 64 + cc * 2; return st * 1024 + (ob ^ (((ob >> 9) & 1) << 5)); }
__host__ __device__ __forceinline__ void stage_rc(int b, int& R, int& C) { const int st = b / 1024, sb = b % 1024, swz = sb ^ (((sb >> 9) & 1) << 5); R = (st >> 1) * 16 + swz / 64; C = (st & 1) * 32 + (swz % 64) / 2; }
__host__ __device__ __forceinline__ int perm32(int rho) { const int n = rho >> 4, i = rho & 15; return 8 * (i >> 2) + 4 * n + (i & 3); }

struct Unit { int pm, pn; };
struct Gemm { const bf16_t* A; const bf16_t* Bt; int M, N, K, lda; };
struct StaticOrder {
    int nM, nN, nwg, G, c;
    __host__ __device__ void init(int M, int N, int G_, int c_) { nM = M / BM; nN = N / BM; nwg = nM * nN; G = G_; c = c_; }
    __host__ __device__ bool next(int i, Unit& u) const {
        const long L = (long)i * G + c; if (L >= nwg) return false;
        int wgid = (int)L; { const int q = nwg / NXCD, r = nwg % NXCD, xcd = wgid % NXCD, off = wgid / NXCD; wgid = (xcd < r ? xcd * (q + 1) : r * (q + 1) + (xcd - r) * q) + off; }
        const int nig = WGM * nN, gid = wgid / nig, fm = gid * WGM, gsz = (nM - fm) < WGM ? (nM - fm) : WGM;
        u.pm = fm + ((wgid % nig) % gsz); u.pn = (wgid % nig) / gsz; return true;
    }
    __device__ __forceinline__ void a_ready(const Unit&) const {}
    __device__ __forceinline__ void done(const Unit&) const {}
};

__device__ __forceinline__ unsigned cvt_pk_bf16(float lo, float hi) { unsigned r; asm volatile("v_cvt_pk_bf16_f32 %0, %1, %2" : "=v"(r) : "v"(lo), "v"(hi)); return r; }
__device__ __forceinline__ float bflo(unsigned w) { return __builtin_bit_cast(float, w << 16); }
__device__ __forceinline__ float bfhi(unsigned w) { return __builtin_bit_cast(float, w & 0xffff0000u); }
__device__ __forceinline__ float sigmoidf_(float v) { return __builtin_amdgcn_rcpf(1.0f + __builtin_amdgcn_exp2f(-1.44269504f * v)); }
struct EpiProj {
    static constexpr bool PERM = true, AFTER_DRAIN = false;
    bf16_t* QKV; bf16_t* G;
    __device__ __forceinline__ void operator()(const f32x4 (&acc)[2][2][4][2], const Unit& u, int wr, int wc, int fr, int fq) const {
        const int row0 = u.pm * BM + wr * 64 + fr; const bool gate = u.pn >= 9;
        bf16_t* base = gate ? G : QKV; const int ldc = gate ? 3072 : 2304; const int col0 = (gate ? (u.pn - 9) : u.pn) * BM + wc * 32 + 8 * fq;
#pragma unroll
        for (int ai = 0; ai < 2; ++ai)
#pragma unroll
            for (int m = 0; m < 4; ++m) { bf16_t* rowp = base + (size_t)(row0 + ai * HALF + m * 16) * ldc + col0;
#pragma unroll
                for (int bj = 0; bj < 2; ++bj) { f32x4 v0 = acc[ai][bj][m][0], v1 = acc[ai][bj][m][1];
                    if (gate) {
#pragma unroll
                        for (int e = 0; e < 4; ++e) { v0[e] = sigmoidf_(v0[e]); v1[e] = sigmoidf_(v1[e]); } }
                    u32x4 w; w.x = cvt_pk_bf16(v0[0], v0[1]); w.y = cvt_pk_bf16(v0[2], v0[3]); w.z = cvt_pk_bf16(v1[0], v1[1]); w.w = cvt_pk_bf16(v1[2], v1[3]);
                    *(u32x4*)(rowp + bj * HALF) = w; } }
    }
};
template <int ACCUM> struct EpiGate {
    static constexpr bool PERM = true, AFTER_DRAIN = false;
    const bf16_t* G; int gcol0; bf16_t* MG;
    __device__ __forceinline__ void operator()(const f32x4 (&acc)[2][2][4][2], const Unit& u, int wr, int wc, int fr, int fq) const {
        const int row0 = u.pm * BM + wr * 64 + fr; const int col0 = u.pn * BM + wc * 32 + 8 * fq;
#pragma unroll
        for (int ai = 0; ai < 2; ++ai)
#pragma unroll
            for (int m = 0; m < 4; ++m) { const size_t r = (size_t)(row0 + ai * HALF + m * 16);
#pragma unroll
                for (int bj = 0; bj < 2; ++bj) { f32x4 v0 = acc[ai][bj][m][0], v1 = acc[ai][bj][m][1];
                    const u32x4 g = *(const u32x4*)(G + r * 3072 + gcol0 + col0 + bj * HALF);
                    v0[0] *= bflo(g.x); v0[1] *= bfhi(g.x); v0[2] *= bflo(g.y); v0[3] *= bfhi(g.y); v1[0] *= bflo(g.z); v1[1] *= bfhi(g.z); v1[2] *= bflo(g.w); v1[3] *= bfhi(g.w);
                    bf16_t* dst = MG + r * 1024 + col0 + bj * HALF;
                    if (ACCUM) { const u32x4 p = *(const u32x4*)dst;
                        v0[0] += bflo(p.x); v0[1] += bfhi(p.x); v0[2] += bflo(p.y); v0[3] += bfhi(p.y); v1[0] += bflo(p.z); v1[1] += bfhi(p.z); v1[2] += bflo(p.w); v1[3] += bfhi(p.w); }
                    u32x4 w; w.x = cvt_pk_bf16(v0[0], v0[1]); w.y = cvt_pk_bf16(v0[2], v0[3]); w.z = cvt_pk_bf16(v1[0], v1[1]); w.w = cvt_pk_bf16(v1[2], v1[3]);
                    *(u32x4*)dst = w; }
                asm volatile("" ::: "memory"); }
    }
};
struct EpiResid {
    static constexpr bool PERM = true, AFTER_DRAIN = false;
    const float* xin; float* out;
    __device__ __forceinline__ void operator()(const f32x4 (&acc)[2][2][4][2], const Unit& u, int wr, int wc, int fr, int fq) const {
        const int row0 = u.pm * BM + wr * 64 + fr; const int col0 = u.pn * BM + wc * 32 + 8 * fq;
#pragma unroll
        for (int ai = 0; ai < 2; ++ai) { asm volatile("" ::: "memory");
#pragma unroll
            for (int m = 0; m < 4; ++m) { const size_t off = (size_t)(row0 + ai * HALF + m * 16) * 1024 + col0;
#pragma unroll
                for (int bj = 0; bj < 2; ++bj) { const float* xi = xin + off + bj * HALF; float* o = out + off + bj * HALF;
                    const f32x4 x0 = *(const f32x4*)xi, x1 = *(const f32x4*)(xi + 4);
                    *(f32x4*)o = x0 + acc[ai][bj][m][0]; *(f32x4*)(o + 4) = x1 + acc[ai][bj][m][1]; } } }
    }
};
template <int CTRL> __device__ __forceinline__ float dpp0(float x) { return __builtin_bit_cast(float, __builtin_amdgcn_update_dpp(0, __builtin_bit_cast(int, x), CTRL, 0xf, 0xf, true)); }
struct EpiUpConv {
    static constexpr bool PERM = true, AFTER_DRAIN = false;
    bf16_t* ACT; bf16_t* HALO; bf16_t* TOP; const float* cw; const float* cb;
    __device__ __forceinline__ void operator()(const f32x4 (&acc)[2][2][4][2], const Unit& u, int wr, int wc, int fr, int fq) const {
        const int row0 = u.pm * BM + wr * 64 + fr; const int ch0 = u.pn * 128 + wc * 32 + 8 * fq;
#pragma unroll
        for (int n = 0; n < 2; ++n) { const int ch = ch0 + 4 * n;
            const f32x4 wg0 = *(const f32x4*)(cw + ch), wg1 = *(const f32x4*)(cw + 5632 + ch), wg2 = *(const f32x4*)(cw + 2 * 5632 + ch), bg = *(const f32x4*)(cb + ch);
            const f32x4 wv0 = *(const f32x4*)(cw + 2816 + ch), wv1 = *(const f32x4*)(cw + 5632 + 2816 + ch), wv2 = *(const f32x4*)(cw + 2 * 5632 + 2816 + ch), bv = *(const f32x4*)(cb + 2816 + ch);
#pragma unroll
            for (int ai = 0; ai < 2; ++ai)
#pragma unroll
                for (int m = 0; m < 4; ++m) { const int row = row0 + ai * HALF + m * 16;
                    const f32x4 g0 = acc[ai][0][m][n], v0 = acc[ai][1][m][n];
                    f32x4 g1, g2, v1, v2;
#pragma unroll
                    for (int e = 0; e < 4; ++e) { g1[e] = dpp0<0x111>(g0[e]); g2[e] = dpp0<0x112>(g0[e]); v1[e] = dpp0<0x111>(v0[e]); v2[e] = dpp0<0x112>(v0[e]); }
                    if (m > 0) { const f32x4 gm = acc[ai][0][m > 0 ? m - 1 : 0][n], vm = acc[ai][1][m > 0 ? m - 1 : 0][n];
#pragma unroll
                        for (int e = 0; e < 4; ++e) { g1[e] += dpp0<0x10F>(gm[e]); g2[e] += dpp0<0x10E>(gm[e]); v1[e] += dpp0<0x10F>(vm[e]); v2[e] += dpp0<0x10E>(vm[e]); } }
                    const f32x4 yg = bg + wg0 * g2 + wg1 * g1 + wg2 * g0, yv = bv + wv0 * v2 + wv1 * v1 + wv2 * v0;
                    f32x4 o;
#pragma unroll
                    for (int e = 0; e < 4; ++e) o[e] = yg[e] * sigmoidf_(yg[e]) * yv[e];
                    typedef unsigned u32x2e __attribute__((ext_vector_type(2)));
                    const bool top = (m == 0) && (fr < 2);
                    if (!top) { u32x2e w; w.x = cvt_pk_bf16(o[0], o[1]); w.y = cvt_pk_bf16(o[2], o[3]); *(u32x2e*)(ACT + (size_t)row * 2816 + ch) = w; }
                    if (top || (m == 3 && fr >= 14)) { bf16_t* sp = (top ? TOP + ((size_t)(row >> 6) * 2 + fr) * 5632 : HALO + ((size_t)(row >> 6) * 2 + (fr - 14)) * 5632) + ch;
                        u32x2e wgr, wvr; wgr.x = cvt_pk_bf16(g0[0], g0[1]); wgr.y = cvt_pk_bf16(g0[2], g0[3]); wvr.x = cvt_pk_bf16(v0[0], v0[1]); wvr.y = cvt_pk_bf16(v0[2], v0[3]);
                        *(u32x2e*)sp = wgr; *(u32x2e*)(sp + 2816) = wvr; } }
        }
    }
};
struct EpiUp {
    static constexpr bool PERM = true, AFTER_DRAIN = false;
    bf16_t* U; bf16_t* HALO;
    __device__ __forceinline__ void operator()(const f32x4 (&acc)[2][2][4][2], const Unit& u, int wr, int wc, int fr, int fq) const {
        const int row0 = u.pm * BM + wr * 64 + fr; const int col0 = u.pn * BM + wc * 32 + 8 * fq;
#pragma unroll
        for (int ai = 0; ai < 2; ++ai)
#pragma unroll
            for (int m = 0; m < 4; ++m) { const int row = row0 + ai * HALF + m * 16; bf16_t* rowp = U + (size_t)row * 5632 + col0;
#pragma unroll
                for (int bj = 0; bj < 2; ++bj) { const f32x4 v0 = acc[ai][bj][m][0], v1 = acc[ai][bj][m][1];
                    u32x4 w; w.x = cvt_pk_bf16(v0[0], v0[1]); w.y = cvt_pk_bf16(v0[2], v0[3]); w.z = cvt_pk_bf16(v1[0], v1[1]); w.w = cvt_pk_bf16(v1[2], v1[3]);
                    *(u32x4*)(rowp + bj * HALF) = w;
                    if (m == 3 && fr >= 14) *(u32x4*)(HALO + ((size_t)(row >> 6) * 2 + (fr - 14)) * 5632 + col0 + bj * HALF) = w; } }
    }
};

template <class Epi, class Sched, bool ALIGN_EPI = false, bool SP2 = false>
__device__ __forceinline__ void gemm_phase(PG8_LAS unsigned char* lds, const Gemm g, const Sched& S, const Epi& E) {
    int tid_ = threadIdx.x; asm volatile("" : "+v"(tid_));
    const int tid = tid_, wid = __builtin_amdgcn_readfirstlane(tid >> 6), lane = tid & 63, wr = wid >> 2, wc = wid & 3, fr = lane & 15, fq = lane >> 4;
    const int K = g.K, nt = K / BK;
    unsigned voffA[2], voffB[2];
#pragma unroll
    for (int i = 0; i < 2; ++i) { int R, C; stage_rc(tid * 16 + i * 8192, R, C); const int Rb = Epi::PERM ? ((R & ~31) + perm32(R & 31)) : R;
        voffA[i] = (unsigned)(R * g.lda + C) * 2u; voffB[i] = (unsigned)(Rb * K + C) * 2u; }
    const size_t kstep = (size_t)(BK * 2);
    const size_t hstepA = (size_t)HALF * g.lda * 2, hstepB = (size_t)HALF * K * 2;
    const size_t tstepA = 2 * hstepA, tstepB = 2 * hstepB;
    const unsigned ldsw = (unsigned)wid * 1024u;
    const int aoff = lds_byte(wr * 64 + fr, fq * 8), boff = lds_byte(wc * 32 + fr, fq * 8);
#define PG8_SA(b, h) (((b) * 2 + (h)) * HTB)
#define PG8_SB(b, h) ((4 + (b) * 2 + (h)) * HTB)
#define PG8_STAGE(bufoff, gbase, voff) do { _Pragma("unroll") for (int _i = 0; _i < 2; ++_i) \
        __builtin_amdgcn_global_load_lds((const unsigned*)((const char*)(gbase) + (voff)[_i]), (PG8_LAS unsigned*)(lds + (bufoff) + ldsw + _i * 8192), 16, 0, 0); } while (0)
#define PG8_LDA(dst, b, h) do { _Pragma("unroll") for (int m = 0; m < 4; ++m) _Pragma("unroll") for (int k = 0; k < 2; ++k) dst[m][k] = *(const PG8_LAS bf16x8*)(lds + PG8_SA(b, h) + aoff + m * 2048 + k * 1024); } while (0)
#define PG8_LDB(dst, b, h) do { _Pragma("unroll") for (int n = 0; n < 2; ++n) _Pragma("unroll") for (int k = 0; k < 2; ++k) dst[n][k] = *(const PG8_LAS bf16x8*)(lds + PG8_SB(b, h) + boff + n * 2048 + k * 1024); } while (0)
#define PG8_MMA(ai, bj, At, Bt) do { __builtin_amdgcn_s_setprio(1); _Pragma("unroll") for (int m = 0; m < 4; ++m) _Pragma("unroll") for (int n = 0; n < 2; ++n) _Pragma("unroll") for (int k = 0; k < 2; ++k) \
        acc[ai][bj][m][n] = __builtin_amdgcn_mfma_f32_16x16x32_bf16(Bt[n][k], At[m][k], acc[ai][bj][m][n], 0, 0, 0); __builtin_amdgcn_s_setprio(0); } while (0)
#define PG8_WAIT_V(n) asm volatile("s_waitcnt vmcnt(" #n ")" ::: "memory")
#define PG8_WAIT_L(n) asm volatile("s_waitcnt lgkmcnt(" #n ")" ::: "memory")
#define PG8_BAR __builtin_amdgcn_s_barrier()
#define PG8_SCHED __builtin_amdgcn_sched_barrier(0)
    Unit cur, nxt; int ui = 0;
    if (!S.next(0, cur)) return;
    f32x4 acc[2][2][4][2];
#pragma unroll
    for (int a = 0; a < 2; ++a)
#pragma unroll
        for (int b = 0; b < 2; ++b)
#pragma unroll
            for (int m = 0; m < 4; ++m)
#pragma unroll
                for (int n = 0; n < 2; ++n) acc[a][b][m][n] = (f32x4){0.f, 0.f, 0.f, 0.f};
    bf16x8 At[4][2], B0[2][2], B1[2][2];
    const char* cA = (const char*)g.A + (size_t)cur.pm * tstepA; const char* cB = (const char*)g.Bt + (size_t)cur.pn * tstepB;
    S.a_ready(cur);
    if constexpr (SP2) {
        PG8_STAGE(PG8_SB(0, 0), cB, voffB); PG8_STAGE(PG8_SB(0, 1), cB + hstepB, voffB); PG8_STAGE(PG8_SA(0, 0), cA, voffA); PG8_STAGE(PG8_SA(0, 1), cA + hstepA, voffA);
        if (wr == 1) PG8_BAR;
        PG8_WAIT_V(2); PG8_BAR;
        PG8_STAGE(PG8_SB(1, 0), cB + kstep, voffB); PG8_STAGE(PG8_SA(1, 0), cA + kstep, voffA); PG8_STAGE(PG8_SB(1, 1), cB + hstepB + kstep, voffB);
        PG8_WAIT_V(6); PG8_BAR;
    } else {
        PG8_STAGE(PG8_SB(0, 0), cB, voffB); PG8_STAGE(PG8_SA(0, 0), cA, voffA); PG8_STAGE(PG8_SB(0, 1), cB + hstepB, voffB); PG8_STAGE(PG8_SA(0, 1), cA + hstepA, voffA);
        if (wr == 1) PG8_BAR;
        PG8_WAIT_V(4); PG8_BAR;
        PG8_STAGE(PG8_SB(1, 0), cB + kstep, voffB); PG8_STAGE(PG8_SA(1, 0), cA + kstep, voffA); PG8_STAGE(PG8_SB(1, 1), cB + hstepB + kstep, voffB);
        PG8_WAIT_V(6); PG8_BAR;
    }
    for (;;) {
        const bool has_next = S.next(ui + 1, nxt);
        const char* nA = has_next ? (const char*)g.A + (size_t)nxt.pm * tstepA : cA; const char* nB = has_next ? (const char*)g.Bt + (size_t)nxt.pn * tstepB : cB;
        for (int t = 0; t < nt; t += 2) {
            const bool last = (t == nt - 2);
            const char* a1 = cA + (size_t)(t + 1) * kstep;
            const char* a2 = last ? nA : cA + (size_t)(t + 2) * kstep; const char* b2 = last ? nB : cB + (size_t)(t + 2) * kstep;
            const char* a3 = a2 + kstep; const char* b3 = b2 + kstep;
            if (last && has_next) S.a_ready(nxt);
            if constexpr (SP2) {
            PG8_LDB(B0, 0, 0); PG8_LDB(B1, 0, 1); PG8_SCHED; PG8_LDA(At, 0, 0); PG8_STAGE(PG8_SA(1, 1), a1 + hstepA, voffA);
            PG8_WAIT_V(8); PG8_WAIT_L(0); PG8_BAR; PG8_MMA(0, 0, At, B0); PG8_MMA(0, 1, At, B1); PG8_BAR; PG8_SCHED;
            PG8_LDA(At, 0, 1); PG8_STAGE(PG8_SB(0, 0), b2, voffB); PG8_STAGE(PG8_SB(0, 1), b2 + hstepB, voffB); PG8_STAGE(PG8_SA(0, 0), a2, voffA);
            PG8_WAIT_V(8); PG8_WAIT_L(0); PG8_BAR; PG8_MMA(1, 0, At, B0); PG8_MMA(1, 1, At, B1); PG8_BAR; PG8_SCHED;
            PG8_LDB(B0, 1, 0); PG8_LDB(B1, 1, 1); PG8_SCHED; PG8_LDA(At, 1, 0); PG8_STAGE(PG8_SA(0, 1), a2 + hstepA, voffA);
            PG8_WAIT_V(8); PG8_WAIT_L(0); PG8_BAR; PG8_MMA(0, 0, At, B0); PG8_MMA(0, 1, At, B1); PG8_BAR; PG8_SCHED;
            PG8_LDA(At, 1, 1); PG8_STAGE(PG8_SB(1, 0), b3, voffB); PG8_STAGE(PG8_SB(1, 1), b3 + hstepB, voffB); PG8_STAGE(PG8_SA(1, 0), a3, voffA);
            PG8_WAIT_V(8); PG8_WAIT_L(0); PG8_BAR; PG8_MMA(1, 0, At, B0); PG8_MMA(1, 1, At, B1); PG8_BAR; PG8_SCHED;
            } else {
            PG8_LDB(B0, 0, 0); PG8_SCHED; PG8_LDA(At, 0, 0); PG8_STAGE(PG8_SA(1, 1), a1 + hstepA, voffA);
            PG8_WAIT_L(8); PG8_BAR; PG8_WAIT_L(0); PG8_MMA(0, 0, At, B0); PG8_BAR; PG8_SCHED;
            PG8_LDB(B1, 0, 1); PG8_STAGE(PG8_SB(0, 0), b2, voffB);
            PG8_BAR; PG8_WAIT_L(0); PG8_MMA(0, 1, At, B1); PG8_BAR;
            PG8_LDA(At, 0, 1); PG8_STAGE(PG8_SA(0, 0), a2, voffA);
            PG8_BAR; PG8_WAIT_L(0); PG8_MMA(1, 0, At, B0); PG8_BAR; PG8_SCHED;
            PG8_STAGE(PG8_SB(0, 1), b2 + hstepB, voffB);
            PG8_WAIT_V(6); PG8_BAR; PG8_MMA(1, 1, At, B1); PG8_BAR;
            PG8_LDB(B0, 1, 0); PG8_SCHED; PG8_LDA(At, 1, 0); PG8_STAGE(PG8_SA(0, 1), a2 + hstepA, voffA);
            PG8_WAIT_L(8); PG8_BAR; PG8_WAIT_L(0); PG8_MMA(0, 0, At, B0); PG8_BAR; PG8_SCHED;
            PG8_LDB(B1, 1, 1); PG8_STAGE(PG8_SB(1, 0), b3, voffB);
            PG8_BAR; PG8_WAIT_L(0); PG8_MMA(0, 1, At, B1); PG8_BAR;
            PG8_LDA(At, 1, 1); PG8_STAGE(PG8_SA(1, 0), a3, voffA);
            PG8_BAR; PG8_WAIT_L(0); PG8_MMA(1, 0, At, B0); PG8_BAR; PG8_SCHED;
            PG8_STAGE(PG8_SB(1, 1), b3 + hstepB, voffB);
            PG8_WAIT_V(6); PG8_BAR; PG8_MMA(1, 1, At, B1); PG8_BAR;
            }
        }
        if constexpr (ALIGN_EPI) { if (wr == 0) PG8_BAR; }
        if constexpr (!Epi::AFTER_DRAIN) { E(acc, cur, wr, wc, fr, fq); S.done(cur); }
        if (!has_next) break;
#pragma unroll
        for (int a = 0; a < 2; ++a)
#pragma unroll
            for (int b = 0; b < 2; ++b)
#pragma unroll
                for (int m = 0; m < 4; ++m)
#pragma unroll
                    for (int n = 0; n < 2; ++n) acc[a][b][m][n] = (f32x4){0.f, 0.f, 0.f, 0.f};
        cur = nxt; cA = nA; cB = nB; ++ui;
        if constexpr (ALIGN_EPI) { if (wr == 1) PG8_BAR; }
    }
    PG8_WAIT_V(0);
    if constexpr (!ALIGN_EPI) { if (wr == 0) PG8_BAR; }
    PG8_BAR;
    if constexpr (Epi::AFTER_DRAIN) { E.fused(acc, cur, wr, wc, fr, fq, lds, wid, lane); S.done(cur); }
#undef PG8_SA
#undef PG8_SB
#undef PG8_STAGE
#undef PG8_LDA
#undef PG8_LDB
#undef PG8_MMA
#undef PG8_WAIT_V
#undef PG8_WAIT_L
#undef PG8_BAR
#undef PG8_SCHED
}
}

#define LAS __attribute__((address_space(3)))
typedef unsigned short bf16;
typedef short bf16x8 __attribute__((ext_vector_type(8)));
typedef float f32x4 __attribute__((ext_vector_type(4)));
typedef float f32x16 __attribute__((ext_vector_type(16)));
typedef unsigned u32x4 __attribute__((ext_vector_type(4)));
typedef unsigned u32x2 __attribute__((ext_vector_type(2)));
constexpr int SEQ = 8192, MTOK = 16384, DM = 1024, NIN = 5376, NQKV = 2304, NGATE = 3072, FF = 2816, FF2 = 5632;
constexpr size_t MiB = 1u << 20;
constexpr size_t WS_CTL = 0, WS_KMP = 64 * 1024;
constexpr size_t WS_W = 1 * MiB;
constexpr size_t W_IN = 0, W_PA = W_IN + (size_t)NIN * DM * 2, W_PB = W_PA + 1024 * 256 * 2, W_PC = W_PB + 1024 * 512 * 2, W_OUT = W_PC + 1024 * 256 * 2,
                 W_UP = W_OUT + 1024 * 1024 * 2, W_DOWN = W_UP + (size_t)FF2 * DM * 2, W_END = W_DOWN + (size_t)DM * FF * 2;
static_assert(W_END <= 31 * MiB, "weights");
constexpr size_t WS_H = 32 * MiB;
constexpr size_t WS_G = 64 * MiB;
constexpr size_t WS_QKV = 160 * MiB;
constexpr size_t WS_VT = 232 * MiB;
constexpr size_t WS_U = 64 * MiB;
constexpr size_t WS_HALO = 240 * MiB;
constexpr size_t WS_TOP = 246 * MiB;
constexpr size_t WS_END = 252 * MiB;
constexpr int LDS_BYTES = 147456;
constexpr int NPH = 20;

struct Args {
    const float* in[24]; float* out; unsigned char* ws;
    float inv64[32]; float inv32[16]; float lam_init[2];
    int ph_lo, ph_hi;
};
enum { I_X = 0, I_ATTN_NORM, I_W_IN, I_QN_A, I_KN_A, I_QN_B, I_KN_B, I_SINKS, I_QN_C, I_KN_C, I_LQ1, I_LK1, I_LQ2, I_LK2, I_SUBLN, I_WPA, I_WPB, I_WPC, I_WOUT, I_MLP_NORM, I_WUP, I_CONVW, I_CONVB, I_WDOWN };

template <class T> __device__ __forceinline__ T* sptr(T* p) { const unsigned long long v = (unsigned long long)p;
    const unsigned lo = __builtin_amdgcn_readfirstlane((unsigned)v), hi = __builtin_amdgcn_readfirstlane((unsigned)(v >> 32));
    return (T*)(__attribute__((address_space(1))) T*)(((unsigned long long)hi << 32) | lo); }

__device__ __forceinline__ unsigned f2bf(float f) { unsigned u = __builtin_bit_cast(unsigned, f); return (u + 0x7fffu + ((u >> 16) & 1u)) >> 16; }
__device__ __forceinline__ unsigned pk2(float lo, float hi) { return pg8::cvt_pk_bf16(lo, hi); }
__device__ __forceinline__ float bf2f(unsigned short v) { return __builtin_bit_cast(float, (unsigned)v << 16); }
__device__ __forceinline__ float wave_sum(float v) {
#pragma unroll
    for (int o = 1; o < 64; o <<= 1) v += __shfl_xor(v, o);
    return v;
}
#define LDS_WAIT() asm volatile("s_waitcnt lgkmcnt(0)" ::: "memory")

__device__ __forceinline__ void transpose_item(const float* W, int K, int N, bf16* WT, LAS float* scr, int item, int lane, bool pair = false) {
    const int nblk = N / 32, kb = item / nblk, nb = item % nblk, k0 = 64 * kb, n0 = 32 * nb;
#pragma unroll 8
    for (int i = 0; i < 32; ++i) { const int kk = 2 * i + (lane >> 5); scr[kk * 33 + (lane & 31)] = W[(size_t)(k0 + kk) * N + n0 + (lane & 31)]; }
    LDS_WAIT(); asm volatile("" ::: "memory");
    const int c = lane & 7;
#pragma unroll
    for (int j = 0; j < 4; ++j) { const int n = (lane >> 3) + 8 * j; const LAS float* s = scr + (8 * c) * 33 + n;
        u32x4 o; o.x = pk2(s[0 * 33], s[1 * 33]); o.y = pk2(s[2 * 33], s[3 * 33]); o.z = pk2(s[4 * 33], s[5 * 33]); o.w = pk2(s[6 * 33], s[7 * 33]);
        int nr = n0 + n; if (pair) { const int isv = nr >= FF ? 1 : 0, chn = nr - isv * FF; nr = 256 * (chn >> 7) + 128 * isv + (chn & 127); }
        *(u32x4*)(WT + (size_t)nr * K + k0 + 8 * c) = o; }
    LDS_WAIT(); asm volatile("" ::: "memory");
}
__device__ __forceinline__ void rms_row_to_bf16(const float* xrow, const float* gain, bf16* orow, int lane) {
    const f32x4* xr = (const f32x4*)xrow + lane; const f32x4* gr = (const f32x4*)gain + lane;
    f32x4 v[4]; float s = 0.f;
#pragma unroll
    for (int j = 0; j < 4; ++j) { v[j] = xr[64 * j]; s += (v[j].x * v[j].x + v[j].y * v[j].y) + (v[j].z * v[j].z + v[j].w * v[j].w); }
    const float rinv = 1.0f / sqrtf(wave_sum(s) * (1.f / DM) + 1e-6f);
    unsigned long long* o8 = (unsigned long long*)orow + lane;
#pragma unroll
    for (int j = 0; j < 4; ++j) { const f32x4 g = gr[64 * j];
        o8[64 * j] = (unsigned long long)pk2(v[j].x * rinv * g.x, v[j].y * rinv * g.y) | ((unsigned long long)pk2(v[j].z * rinv * g.z, v[j].w * rinv * g.w) << 32); }
}

__device__ __forceinline__ void phase_convert(const LAS Args& a, int layer, LAS unsigned char* lds) {
    int tid_ = threadIdx.x; asm volatile("" : "+v"(tid_));
    const int lane = tid_ & 63, wave = tid_ >> 6, gw = blockIdx.x * 8 + wave, NGW = gridDim.x * 8;
    LAS float* scr = (LAS float*)(lds + wave * 16384);
    bf16* Wb = (bf16*)(sptr(a.ws) + WS_W);
    constexpr int I0 = 16 * (NIN / 32), I1 = 4 * 32, I2 = 8 * 32, I3 = 4 * 32, I4 = 16 * 32, I5 = 16 * (FF2 / 32), I6 = (FF / 64) * 32;
    constexpr int NIT = I0 + I1 + I2 + I3 + I4 + I5 + I6;
    for (int it = gw; it < NIT; it += NGW) {
        int r = it;
        if (r < I0) { transpose_item(sptr(a.in[I_W_IN]) + (size_t)layer * DM * NIN, DM, NIN, (bf16*)((char*)Wb + W_IN), scr, r, lane); continue; } r -= I0;
        if (r < I1) { transpose_item(sptr(a.in[I_WPA]) + (size_t)layer * 256 * DM, 256, DM, (bf16*)((char*)Wb + W_PA), scr, r, lane); continue; } r -= I1;
        if (r < I2) { transpose_item(sptr(a.in[I_WPB]) + (size_t)layer * 512 * DM, 512, DM, (bf16*)((char*)Wb + W_PB), scr, r, lane); continue; } r -= I2;
        if (r < I3) { transpose_item(sptr(a.in[I_WPC]) + (size_t)layer * 256 * DM, 256, DM, (bf16*)((char*)Wb + W_PC), scr, r, lane); continue; } r -= I3;
        if (r < I4) { transpose_item(sptr(a.in[I_WOUT]) + (size_t)layer * DM * DM, DM, DM, (bf16*)((char*)Wb + W_OUT), scr, r, lane); continue; } r -= I4;
        if (r < I5) { transpose_item(sptr(a.in[I_WUP]) + (size_t)layer * DM * FF2, DM, FF2, (bf16*)((char*)Wb + W_UP), scr, r, lane, true); continue; } r -= I5;
        transpose_item(sptr(a.in[I_WDOWN]) + (size_t)layer * FF * DM, FF, DM, (bf16*)((char*)Wb + W_DOWN), scr, r, lane);
    }
}
__device__ __forceinline__ void phase_norm(const float* x, const float* gain, bf16* H) {
    int tid_ = threadIdx.x; asm volatile("" : "+v"(tid_));
    const int lane = tid_ & 63, wave = tid_ >> 6, gw = blockIdx.x * 8 + wave, NGW = gridDim.x * 8;
    for (int m = gw; m < MTOK; m += NGW) rms_row_to_bf16(x + (size_t)m * DM, gain, H + (size_t)m * DM, lane);
}

template <int CTRL> __device__ __forceinline__ float dppf(float x) { return __builtin_bit_cast(float, __builtin_amdgcn_mov_dpp(__builtin_bit_cast(int, x), CTRL, 0xf, 0xf, true)); }
__device__ __forceinline__ float row16_sum(float x) { x += dppf<0xB1>(x); x += dppf<0x4E>(x); x += dppf<0x141>(x); x += dppf<0x128>(x); return x; }
__device__ __forceinline__ void sincos_rev(float ang, float& s, float& c) {
    const float k = rintf(ang * 0.15915494309f);
    float r = fmaf(-k, 6.28125f, ang); r = fmaf(-k, 1.9353071795864769e-3f, r);
    const float f = r * 0.15915494309f;
    s = __builtin_amdgcn_sinf(f); c = __builtin_amdgcn_cosf(f);
}
__device__ __forceinline__ void phase_prep(const LAS Args& a, int layer, LAS unsigned char* lds) {
    int tid_ = threadIdx.x; asm volatile("" : "+v"(tid_));
    const int tid = tid_, lane = tid & 63, wave = tid >> 6;
    bf16* QKV = (bf16*)(sptr(a.ws) + WS_QKV); bf16* VT = (bf16*)(sptr(a.ws) + WS_VT); float* KMP = (float*)(sptr(a.ws) + WS_KMP);
    LAS unsigned short* vt = (LAS unsigned short*)lds;
    LAS float* kms = (LAS float*)(lds + 10 * 64 * 68 * 2);
    const float gqa = sptr(a.in[I_QN_A])[layer * 64 + lane], gka = sptr(a.in[I_KN_A])[layer * 64 + lane], gqb = sptr(a.in[I_QN_B])[layer * 64 + lane], gkb = sptr(a.in[I_KN_B])[layer * 64 + lane];
    const float gqc = sptr(a.in[I_QN_C])[layer * 32 + (lane & 31)], gkc = sptr(a.in[I_KN_C])[layer * 32 + (lane & 31)];
    const float iv64 = a.inv64[lane & 31], iv32 = a.inv32[lane & 15];
    const float sg64 = (lane & 32) ? 1.f : -1.f, sg32 = (lane & 16) ? 1.f : -1.f;
    const float QS64 = 0.125f * 1.44269504f, QS32 = 0.17677669529f * 1.44269504f;
    for (int c = blockIdx.x; c < MTOK / 64; c += gridDim.x) {
        const int tb = 64 * c, b = tb / SEQ, spos0 = tb % SEQ;
        float kacc[4] = {0.f, 0.f, 0.f, 0.f};
        unsigned short vn[36];
        { const bf16* r0 = QKV + (size_t)(tb + wave * 8) * NQKV;
#pragma unroll
            for (int s = 0; s < 36; ++s) vn[s] = r0[64 * s + lane]; }
#pragma unroll 1
        for (int i = 0; i < 8; ++i) {
            const int p64 = wave * 8 + i, tok = tb + p64, pos = spos0 + p64;
            bf16* row = QKV + (size_t)tok * NQKV;
            float v[36];
#pragma unroll
            for (int s = 0; s < 36; ++s) v[s] = bf2f(vn[s]);
            if (i < 7) { const bf16* rn = row + NQKV;
#pragma unroll
                for (int s = 0; s < 36; ++s) vn[s] = rn[64 * s + lane]; }
            float s64, c64, s32, c32; sincos_rev((float)pos * iv64, s64, c64); sincos_rev((float)pos * iv32, s32, c32);
            s64 *= sg64; s32 *= sg32;
            const int k16 = p64 & 15, ppos = (p64 & ~15) | (8 * ((k16 >> 2) & 1) + 4 * ((k16 >> 3) & 1) + (k16 & 3));
#pragma unroll
            for (int s = 0; s < 36; ++s) {
                const bool isv = (s >= 8 && s < 12) || (s >= 22 && s < 24) || (s >= 32);
                if (isv) { const int hv = s < 12 ? s - 8 : (s < 24 ? 4 + s - 22 : 6 + s - 32); vt[(hv * 64 + lane) * 68 + ppos] = (unsigned short)f2bf(v[s]); continue; }
                const bool isc = s >= 24;
                float x = v[s], ss = x * x;
                ss = row16_sum(ss); ss += __shfl_xor(ss, 16);
                if (!isc) ss += __shfl_xor(ss, 32);
                const float rinv = 1.0f / sqrtf(ss * (isc ? (1.f / 32.f) : (1.f / 64.f)) + 1e-6f);
                float g, qs = 1.f;
                if (s < 4) { g = gqa; qs = QS64; } else if (s < 8) g = gka; else if (s < 20) { g = gqb; qs = QS64; } else if (s < 22) g = gkb; else if (s < 28) { g = gqc; qs = QS32; } else g = gkc;
                x = x * rinv * g;
                const float partner = __shfl_xor(x, isc ? 16 : 32);
                const float y = isc ? (x * c32 + partner * s32) : (x * c64 + partner * s64);
                if (s >= 4 && s < 8) kacc[s - 4] += y;
                row[64 * s + lane] = (unsigned short)f2bf(y * qs);
            }
        }
#pragma unroll
        for (int h = 0; h < 4; ++h) kms[(wave * 4 + h) * 64 + lane] = kacc[h];
        __syncthreads();
        if (tid < 256) { float s = 0.f;
#pragma unroll
            for (int w = 0; w < 8; ++w) s += kms[w * 256 + tid];
            KMP[(size_t)c * 256 + tid] = s; }
#pragma unroll
        for (int j = 0; j < 10; ++j) { const int idx = tid + 512 * j, r = idx >> 3, ch = idx & 7, hv = r >> 6, dv = r & 63;
            const LAS u32x2* src = (const LAS u32x2*)(lds + (size_t)r * 136 + ch * 16);
            const u32x2 lo = src[0], hi = src[1]; u32x4 o; o.x = lo.x; o.y = lo.y; o.z = hi.x; o.w = hi.y;
            *(u32x4*)(VT + (((size_t)b * 10 + hv) * 64 + dv) * SEQ + spos0 + 8 * ch) = o; }
        __syncthreads();
    }
}

#ifndef ATM
#define ATM 7
#endif
#define MFMA32(a, b, c) __builtin_amdgcn_mfma_f32_32x32x16_bf16((a), (b), (c), 0, 0, 0)
__device__ __forceinline__ bf16x8 pack8(float p0, float p1, float p2, float p3, float p4, float p5, float p6, float p7) {
    u32x4 p;
    asm volatile("v_cvt_pk_bf16_f32 %0, %4, %5\n\tv_cvt_pk_bf16_f32 %1, %6, %7\n\tv_cvt_pk_bf16_f32 %2, %8, %9\n\tv_cvt_pk_bf16_f32 %3, %10, %11\n\ts_nop 1"
                 : "=&v"(p[0]), "=&v"(p[1]), "=&v"(p[2]), "=&v"(p[3]) : "v"(p0), "v"(p1), "v"(p2), "v"(p3), "v"(p4), "v"(p5), "v"(p6), "v"(p7));
    return __builtin_bit_cast(bf16x8, p);
}
constexpr int AT_K = 0, AT_V = 18432, AT_KM = 36864, AT_MISC = 45056;
constexpr int NUNITS = 896;

template <int MODE>
__device__ __forceinline__ void attn_unit(const LAS Args& a, int layer, LAS unsigned char* lds, int b, int head, int qt) {
    int tid_ = threadIdx.x; asm volatile("" : "+v"(tid_));
    const int tid = tid_, lane = tid & 63, wave = __builtin_amdgcn_readfirstlane(tid >> 6), qrow = lane & 31, hh = lane >> 5;
    const int q0 = qt * 256, q0w = q0 + wave * 32, qpos = q0w + qrow;
    const size_t tok = (size_t)b * SEQ + qpos;
    const bf16* QKV = (const bf16*)(sptr(a.ws) + WS_QKV); const bf16* VT = (const bf16*)(sptr(a.ws) + WS_VT); bf16* Y = (bf16*)(sptr(a.ws) + WS_H);
    const int qcol = MODE == 0 ? head * 64 : (MODE == 1 ? 768 + head * 64 : 1536 + head * 64);
    const int kcol = MODE == 0 ? 256 + head * 64 : (MODE == 1 ? 1280 + (head >> 2) * 64 : 1792 + head * 64);
    const int hv = MODE == 0 ? head : (MODE == 1 ? 4 + (head >> 2) : 6 + head);
    const int ycol = MODE == 0 ? head * 64 : (MODE == 1 ? 256 + head * 64 : 768 + head * 64);
    volatile LAS unsigned* misc = (volatile LAS unsigned*)(lds + AT_MISC);
    bf16x8 qf[4];
#pragma unroll
    for (int i = 0; i < 4; ++i) qf[i] = *(const bf16x8*)(QKV + tok * NQKV + qcol + 16 * i + 8 * hh);
    unsigned mymask = 0u, umask = 0u;
    if (MODE == 0) {
        if (qt <= 3) { mymask = (1u << qt) - 1u; umask = mymask; }
        else {
            LAS float* kml = (LAS float*)(lds + AT_KM);
            const float* KMP = (const float*)(sptr(a.ws) + WS_KMP);
            for (int idx = tid; idx < qt * 64; idx += 512) { const int j = idx >> 6, d = idx & 63; const float* p = KMP + ((size_t)(b * 128 + 4 * j) * 4 + head) * 64 + d;
                kml[idx] = (p[0] + p[256] + p[512] + p[768]) * (1.f / 256.f); }
            if (tid == 0) misc[2] = 0u;
            __syncthreads();
            float qv[32];
#pragma unroll
            for (int i = 0; i < 4; ++i) { const u32x4 w = *(const u32x4*)(QKV + tok * NQKV + qcol + 32 * hh + 8 * i);
                qv[8 * i + 0] = pg8::bflo(w.x); qv[8 * i + 1] = pg8::bfhi(w.x); qv[8 * i + 2] = pg8::bflo(w.y); qv[8 * i + 3] = pg8::bfhi(w.y);
                qv[8 * i + 4] = pg8::bflo(w.z); qv[8 * i + 5] = pg8::bfhi(w.z); qv[8 * i + 6] = pg8::bflo(w.w); qv[8 * i + 7] = pg8::bfhi(w.w); }
            float v0 = -INFINITY, v1 = -INFINITY, v2 = -INFINITY; int i0 = 0, i1 = 0, i2 = 0;
            for (int j = 0; j < qt; ++j) {
                const LAS f32x4* kr = (const LAS f32x4*)(kml + j * 64 + 32 * hh);
                float acc = 0.f;
#pragma unroll
                for (int i = 0; i < 8; ++i) { const f32x4 kk = kr[i]; acc += qv[4 * i] * kk.x + qv[4 * i + 1] * kk.y + qv[4 * i + 2] * kk.z + qv[4 * i + 3] * kk.w; }
                const float g = acc + __shfl_xor(acc, 32);
                if (g > v0) { v2 = v1; i2 = i1; v1 = v0; i1 = i0; v0 = g; i0 = j; }
                else if (g > v1) { v2 = v1; i2 = i1; v1 = g; i1 = j; }
                else if (g > v2) { v2 = g; i2 = j; }
            }
            mymask = (1u << i0) | (1u << i1) | (1u << i2);
            atomicOr((unsigned*)(lds + AT_MISC) + 2, mymask);
            __syncthreads();
            umask = misc[2];
        }
    }
    float lam = 0.f, sinkv = 0.f;
    if (MODE == 2) { float t1 = 0.f, t2 = 0.f;
        if (lane < 32) { t1 = sptr(a.in[I_LQ1])[layer * 32 + lane] * sptr(a.in[I_LK1])[layer * 32 + lane]; t2 = sptr(a.in[I_LQ2])[layer * 32 + lane] * sptr(a.in[I_LK2])[layer * 32 + lane]; }
        lam = expf(wave_sum(t1)) - expf(wave_sum(t2)) + a.lam_init[layer]; }
    if (MODE == 1) sinkv = __builtin_amdgcn_exp2f(sptr(a.in[I_SINKS])[layer * 8 + head] * 1.44269504f);

    const int kt_hi = 4 * (qt + 1);
    int kt = 0;
    if (MODE == 1) kt = q0 >= 128 ? (q0 - 128) / 64 : 0;
#define VALID_TILE(t) (MODE != 0 || ((t) >> 2) == qt || ((umask >> ((t) >> 2)) & 1u))
    while (!VALID_TILE(kt)) ++kt;
    const int lrow = tid >> 3, lch = tid & 7;
    const bf16* kg = QKV + ((size_t)b * SEQ + lrow) * NQKV + kcol + 8 * lch;
    const bf16* vg = VT + (((size_t)b * 10 + hv) * 64 + lrow) * SEQ + 8 * lch;
    const int st_off = lrow * 144 + lch * 16;
    u32x4 kreg = *(const u32x4*)(kg + (size_t)(kt * 64) * NQKV), vreg = *(const u32x4*)(vg + kt * 64);
    *(LAS u32x4*)(lds + AT_K + st_off) = kreg; *(LAS u32x4*)(lds + AT_V + st_off) = vreg;
    __syncthreads();
    f32x16 o1[2], o2[2]; float l1 = 0.f, l2 = 0.f;
#pragma unroll
    for (int d = 0; d < 2; ++d)
#pragma unroll
        for (int i = 0; i < 16; ++i) { o1[d][i] = 0.f; o2[d][i] = 0.f; }
    int buf = 0;
    while (kt < kt_hi) {
        int nkt = kt + 1;
        while (nkt < kt_hi && !VALID_TILE(nkt)) ++nkt;
        const bool has_next = nkt < kt_hi;
        if (has_next) { kreg = *(const u32x4*)(kg + (size_t)(nkt * 64) * NQKV); vreg = *(const u32x4*)(vg + nkt * 64); }
#pragma unroll 1
        for (int sub = 0; sub < 2; ++sub) {
            const int k0s = kt * 64 + 32 * sub;
            bool skip, needmask = false, past = false; unsigned uwin = 0x7fffffffu; bool bit = true;
            if (MODE == 1) { skip = (k0s > q0w + 31) || (k0s + 31 + 127 < q0w); needmask = !((k0s + 31 <= q0w) && (k0s + 127 >= q0w + 31)); uwin = 128u; }
            else if (MODE == 0 && (kt >> 2) != qt) { past = true; bit = (mymask >> (kt >> 2)) & 1u; skip = (__ballot(bit) == 0ull); }
            else { skip = k0s > q0w + 31; needmask = k0s + 31 > q0w; }
            if (skip) continue;
            f32x16 S1, S2;
#pragma unroll
            for (int i = 0; i < 16; ++i) { S1[i] = 0.f; S2[i] = 0.f; }
            const LAS unsigned char* kb = lds + AT_K + buf * 9216 + (32 * sub + qrow) * 144 + hh * 16;
#pragma unroll
            for (int i = 0; i < 4; ++i) { const bf16x8 kf = *(const LAS bf16x8*)(kb + i * 32);
                if (MODE == 2 && i >= 2) S2 = MFMA32(kf, qf[i], S2); else S1 = MFMA32(kf, qf[i], S1); }
            const int dbase = qpos - k0s - 4 * hh;
            float p1[16], p2[16];
#define EXPL(MASKED) _Pragma("unroll") for (int i = 0; i < 16; ++i) { \
                const int ci = (i & 3) + 8 * (i >> 2); \
                float e1 = __builtin_amdgcn_exp2f(S1[i]), e2 = 0.f; \
                if (MODE == 2) e2 = __builtin_amdgcn_exp2f(S2[i]); \
                if (MASKED) { const bool ok = past ? bit : ((unsigned)(dbase - ci) < uwin); e1 = ok ? e1 : 0.f; e2 = ok ? e2 : 0.f; } \
                l1 += e1; p1[i] = e1; \
                if (MODE == 2) { l2 += e2; p2[i] = e2; } }
            if (needmask || past) { EXPL(true) } else { EXPL(false) }
#undef EXPL
            bf16x8 pf1[2], pf2[2];
#pragma unroll
            for (int s = 0; s < 2; ++s) { pf1[s] = pack8(p1[8 * s], p1[8 * s + 1], p1[8 * s + 2], p1[8 * s + 3], p1[8 * s + 4], p1[8 * s + 5], p1[8 * s + 6], p1[8 * s + 7]);
                if (MODE == 2) pf2[s] = pack8(p2[8 * s], p2[8 * s + 1], p2[8 * s + 2], p2[8 * s + 3], p2[8 * s + 4], p2[8 * s + 5], p2[8 * s + 6], p2[8 * s + 7]); }
            const LAS unsigned char* vb = lds + AT_V + buf * 9216 + qrow * 144 + (32 * sub + 8 * hh) * 2;
#pragma unroll
            for (int d = 0; d < 2; ++d)
#pragma unroll
                for (int s = 0; s < 2; ++s) { const bf16x8 vf = *(const LAS bf16x8*)(vb + d * (32 * 144) + s * 32);
                    o1[d] = MFMA32(vf, pf1[s], o1[d]);
                    if (MODE == 2) o2[d] = MFMA32(vf, pf2[s], o2[d]); }
        }
        if (has_next) { *(LAS u32x4*)(lds + AT_K + (buf ^ 1) * 9216 + st_off) = kreg; *(LAS u32x4*)(lds + AT_V + (buf ^ 1) * 9216 + st_off) = vreg; }
        __syncthreads();
        buf ^= 1; kt = nkt;
    }
#undef VALID_TILE
    l1 += __shfl_xor(l1, 32);
    if (MODE == 1) l1 += sinkv;
    const float inv1 = 1.0f / l1;
    bf16* yrow = Y + tok * DM + ycol + 4 * hh;
    if (MODE != 2) {
#pragma unroll
        for (int d = 0; d < 2; ++d)
#pragma unroll
            for (int g = 0; g < 4; ++g) { u32x2 w; w.x = pk2(o1[d][4 * g] * inv1, o1[d][4 * g + 1] * inv1); w.y = pk2(o1[d][4 * g + 2] * inv1, o1[d][4 * g + 3] * inv1);
                *(u32x2*)(yrow + 32 * d + 8 * g) = w; }
    } else {
        l2 += __shfl_xor(l2, 32);
        const float c2 = lam / l2; float ss = 0.f;
#pragma unroll
        for (int d = 0; d < 2; ++d)
#pragma unroll
            for (int i = 0; i < 16; ++i) { const float o = o1[d][i] * inv1 - o2[d][i] * c2; o1[d][i] = o; ss += o * o; }
        ss += __shfl_xor(ss, 32);
        const float r = (1.0f - a.lam_init[layer]) / sqrtf(ss * (1.f / 64.f) + 1e-6f);
        const float* sg = sptr(a.in[I_SUBLN]) + layer * 64 + 4 * hh;
#pragma unroll
        for (int d = 0; d < 2; ++d)
#pragma unroll
            for (int g = 0; g < 4; ++g) { const f32x4 gg = *(const f32x4*)(sg + 32 * d + 8 * g);
                u32x2 w; w.x = pk2(o1[d][4 * g] * r * gg.x, o1[d][4 * g + 1] * r * gg.y); w.y = pk2(o1[d][4 * g + 2] * r * gg.z, o1[d][4 * g + 3] * r * gg.w);
                *(u32x2*)(yrow + 32 * d + 8 * g) = w; }
    }
}
constexpr int MO_OACC = 46080, MO_IDX = 112640, MO_CNTW = 120832, MO_TOT = 121856, MO_TASKS = 121984;
__device__ __forceinline__ void attn_moba(const LAS Args& a, int layer, LAS unsigned char* lds, int b, int head, int qt) {
    int tid_ = threadIdx.x; asm volatile("" : "+v"(tid_));
    const int tid = tid_, lane = tid & 63, wave = __builtin_amdgcn_readfirstlane(tid >> 6), qrow = lane & 31, hh = lane >> 5;
    const int q0 = qt * 256, q0w = q0 + wave * 32, qpos = q0w + qrow, own = qt;
    const size_t tok = (size_t)b * SEQ + qpos;
    const bf16* QKV = (const bf16*)(sptr(a.ws) + WS_QKV); const bf16* VT = (const bf16*)(sptr(a.ws) + WS_VT); bf16* Y = (bf16*)(sptr(a.ws) + WS_H);
    const int qcol = head * 64, kcol = 256 + head * 64, hv = head, ycol = head * 64;
    volatile LAS unsigned* misc = (volatile LAS unsigned*)(lds + AT_MISC);
    LAS float* oacc = (LAS float*)(lds + MO_OACC);
    LAS unsigned char* idxl = (LAS unsigned char*)(lds + MO_IDX);
    LAS unsigned* cntw = (LAS unsigned*)(lds + MO_CNTW);
    LAS unsigned* tot = (LAS unsigned*)(lds + MO_TOT);
    LAS unsigned short* tasks = (LAS unsigned short*)(lds + MO_TASKS);
    unsigned mymask = 0u;
    if (own <= 3) mymask = (1u << own) - 1u;
    else {
        LAS float* kml = (LAS float*)(lds + AT_KM);
        const float* KMP = (const float*)(sptr(a.ws) + WS_KMP);
        for (int idx = tid; idx < own * 64; idx += 512) { const int j = idx >> 6, d = idx & 63; const float* p = KMP + ((size_t)(b * 128 + 4 * j) * 4 + head) * 64 + d;
            kml[idx] = (p[0] + p[256] + p[512] + p[768]) * (1.f / 256.f); }
        __syncthreads();
        float qv[32];
#pragma unroll
        for (int i = 0; i < 4; ++i) { const u32x4 w = *(const u32x4*)(QKV + tok * NQKV + qcol + 32 * hh + 8 * i);
            qv[8 * i + 0] = pg8::bflo(w.x); qv[8 * i + 1] = pg8::bfhi(w.x); qv[8 * i + 2] = pg8::bflo(w.y); qv[8 * i + 3] = pg8::bfhi(w.y);
            qv[8 * i + 4] = pg8::bflo(w.z); qv[8 * i + 5] = pg8::bfhi(w.z); qv[8 * i + 6] = pg8::bflo(w.w); qv[8 * i + 7] = pg8::bfhi(w.w); }
        float v0 = -INFINITY, v1 = -INFINITY, v2 = -INFINITY; int i0 = 0, i1 = 0, i2 = 0;
        for (int j = 0; j < own; ++j) {
            const LAS f32x4* kr = (const LAS f32x4*)(kml + j * 64 + 32 * hh);
            float acc = 0.f;
#pragma unroll
            for (int i = 0; i < 8; ++i) { const f32x4 kk = kr[i]; acc += qv[4 * i] * kk.x + qv[4 * i + 1] * kk.y + qv[4 * i + 2] * kk.z + qv[4 * i + 3] * kk.w; }
            const float g = acc + __shfl_xor(acc, 32);
            if (g > v0) { v2 = v1; i2 = i1; v1 = v0; i1 = i0; v0 = g; i0 = j; }
            else if (g > v1) { v2 = v1; i2 = i1; v1 = g; i1 = j; }
            else if (g > v2) { v2 = g; i2 = j; }
        }
        mymask = (1u << i0) | (1u << i1) | (1u << i2);
    }
    for (int i = tid; i < 256 * 65; i += 512) oacc[i] = 0.f;
    for (int j = 0; j < own; ++j) { const unsigned long long bal = __ballot(((mymask >> j) & 1u) && hh == 0);
        if (lane == 0) cntw[j * 8 + wave] = (unsigned)__popcll(bal); }
    __syncthreads();
    for (int j = 0; j < own; ++j) { const bool sel = ((mymask >> j) & 1u) && hh == 0; const unsigned long long bal = __ballot(sel);
        unsigned base = 0u;
        for (int w = 0; w < wave; ++w) base += cntw[j * 8 + w];
        const unsigned pos = base + (unsigned)__popcll(bal & ((1ull << lane) - 1ull));
        if (sel) idxl[j * 256 + pos] = (unsigned char)(wave * 32 + qrow);
        if (wave == 7 && lane == 0) tot[j] = base + (unsigned)__popcll(bal); }
    __syncthreads();
    if (tid == 0) { unsigned n = 0u;
        for (int j = 0; j < own; ++j) { const unsigned nch = (tot[j] + 31u) >> 5; for (unsigned c = 0; c < nch; ++c) tasks[n++] = (unsigned short)(j | (c << 8)); }
        misc[3] = n; }
    __syncthreads();
    const int ntasks = (int)misc[3];
    for (int t = wave; t < ntasks; t += 8) {
        const unsigned tk = tasks[t]; const int j = tk & 255, c = tk >> 8; const int tj = (int)tot[j];
        const int slot = 32 * c + qrow; const bool valid = slot < tj;
        const int qi = idxl[j * 256 + (valid ? slot : 32 * c)];
        const bf16* qp = QKV + ((size_t)b * SEQ + q0 + qi) * NQKV + qcol + 8 * hh;
        bf16x8 qg[4];
#pragma unroll
        for (int i = 0; i < 4; ++i) qg[i] = *(const bf16x8*)(qp + 16 * i);
        const bf16* kcoal = QKV + ((size_t)b * SEQ + 256 * j + (lane >> 3)) * NQKV + kcol + 8 * (lane & 7);
        LAS unsigned char* kst = lds + wave * 4608;
        const int kst_w = (lane >> 3) * 144 + (lane & 7) * 16, kst_r = qrow * 144 + hh * 16;
        const bf16* vbase = VT + (((size_t)b * 10 + hv) * 64 + qrow) * SEQ + 256 * j + 8 * hh;
        f32x16 og[2]; float lg = 0.f;
#pragma unroll
        for (int d = 0; d < 2; ++d)
#pragma unroll
            for (int i = 0; i < 16; ++i) og[d][i] = 0.f;
        u32x4 kc[4]; bf16x8 vc[4];
#pragma unroll
        for (int i = 0; i < 4; ++i) { kc[i] = *(const u32x4*)(kcoal + (size_t)(8 * i) * NQKV); vc[i] = *(const bf16x8*)(vbase + (size_t)(i >> 1) * 32 * SEQ + 16 * (i & 1)); }
#pragma unroll 4
        for (int sub = 0; sub < 8; ++sub) {
#pragma unroll
            for (int i = 0; i < 4; ++i) *(LAS u32x4*)(kst + kst_w + i * (8 * 144)) = kc[i];
            u32x4 kn[4]; bf16x8 vn[4];
            if (sub < 7) {
#pragma unroll
                for (int i = 0; i < 4; ++i) { kn[i] = *(const u32x4*)(kcoal + (size_t)(32 * (sub + 1) + 8 * i) * NQKV);
                    vn[i] = *(const bf16x8*)(vbase + (size_t)(i >> 1) * 32 * SEQ + 32 * (sub + 1) + 16 * (i & 1)); } }
            f32x16 S;
#pragma unroll
            for (int i = 0; i < 16; ++i) S[i] = 0.f;
#pragma unroll
            for (int i = 0; i < 4; ++i) { const bf16x8 kf = *(const LAS bf16x8*)(kst + kst_r + i * 32); S = MFMA32(kf, qg[i], S); }
            float p[16];
#pragma unroll
            for (int i = 0; i < 16; ++i) { p[i] = __builtin_amdgcn_exp2f(S[i]); lg += p[i]; }
            bf16x8 pf[2];
#pragma unroll
            for (int s = 0; s < 2; ++s) pf[s] = pack8(p[8 * s], p[8 * s + 1], p[8 * s + 2], p[8 * s + 3], p[8 * s + 4], p[8 * s + 5], p[8 * s + 6], p[8 * s + 7]);
#pragma unroll
            for (int i = 0; i < 4; ++i) og[i >> 1] = MFMA32(vc[i], pf[i & 1], og[i >> 1]);
            if (sub < 7) {
#pragma unroll
                for (int i = 0; i < 4; ++i) { kc[i] = kn[i]; vc[i] = vn[i]; } }
        }
        if (valid) { LAS float* row = oacc + qi * 65;
#pragma unroll
            for (int d = 0; d < 2; ++d)
#pragma unroll
                for (int i = 0; i < 16; ++i) (void)__hip_atomic_fetch_add(row + 32 * d + (i & 3) + 8 * (i >> 2) + 4 * hh, og[d][i], __ATOMIC_RELAXED, __HIP_MEMORY_SCOPE_WORKGROUP);
            (void)__hip_atomic_fetch_add(row + 64, lg, __ATOMIC_RELAXED, __HIP_MEMORY_SCOPE_WORKGROUP); }
    }
    bf16x8 qf[4];
#pragma unroll
    for (int i = 0; i < 4; ++i) qf[i] = *(const bf16x8*)(QKV + tok * NQKV + qcol + 16 * i + 8 * hh);
    const int lrow = tid >> 3, lch = tid & 7;
    const bf16* kg = QKV + ((size_t)b * SEQ + lrow) * NQKV + kcol + 8 * lch;
    const bf16* vg = VT + (((size_t)b * 10 + hv) * 64 + lrow) * SEQ + 8 * lch;
    const int st_off = lrow * 144 + lch * 16;
    int kt = 4 * own; const int kt_hi = 4 * own + 4;
    u32x4 kreg = *(const u32x4*)(kg + (size_t)(kt * 64) * NQKV), vreg = *(const u32x4*)(vg + kt * 64);
    __syncthreads();
    *(LAS u32x4*)(lds + AT_K + st_off) = kreg; *(LAS u32x4*)(lds + AT_V + st_off) = vreg;
    __syncthreads();
    f32x16 o1[2]; float l1 = 0.f;
#pragma unroll
    for (int d = 0; d < 2; ++d)
#pragma unroll
        for (int i = 0; i < 16; ++i) o1[d][i] = 0.f;
    int buf = 0;
    while (kt < kt_hi) {
        const int nkt = kt + 1; const bool has_next = nkt < kt_hi;
        if (has_next) { kreg = *(const u32x4*)(kg + (size_t)(nkt * 64) * NQKV); vreg = *(const u32x4*)(vg + nkt * 64); }
#pragma unroll 1
        for (int sub = 0; sub < 2; ++sub) {
            const int k0s = kt * 64 + 32 * sub;
            if (k0s > q0w + 31) continue;
            const bool needmask = k0s + 31 > q0w;
            f32x16 S1;
#pragma unroll
            for (int i = 0; i < 16; ++i) S1[i] = 0.f;
            const LAS unsigned char* kb = lds + AT_K + buf * 9216 + (32 * sub + qrow) * 144 + hh * 16;
#pragma unroll
            for (int i = 0; i < 4; ++i) { const bf16x8 kf = *(const LAS bf16x8*)(kb + i * 32); S1 = MFMA32(kf, qf[i], S1); }
            const int dbase = qpos - k0s - 4 * hh;
            float p1[16];
#define EXPL(MASKED) _Pragma("unroll") for (int i = 0; i < 16; ++i) { \
                const int ci = (i & 3) + 8 * (i >> 2); \
                float e1 = __builtin_amdgcn_exp2f(S1[i]); \
                if (MASKED) e1 = (dbase - ci) >= 0 ? e1 : 0.f; \
                l1 += e1; p1[i] = e1; }
            if (needmask) { EXPL(true) } else { EXPL(false) }
#undef EXPL
            bf16x8 pf1[2];
#pragma unroll
            for (int s = 0; s < 2; ++s) pf1[s] = pack8(p1[8 * s], p1[8 * s + 1], p1[8 * s + 2], p1[8 * s + 3], p1[8 * s + 4], p1[8 * s + 5], p1[8 * s + 6], p1[8 * s + 7]);
            const LAS unsigned char* vb = lds + AT_V + buf * 9216 + qrow * 144 + (32 * sub + 8 * hh) * 2;
#pragma unroll
            for (int d = 0; d < 2; ++d)
#pragma unroll
                for (int s = 0; s < 2; ++s) { const bf16x8 vf = *(const LAS bf16x8*)(vb + d * (32 * 144) + s * 32); o1[d] = MFMA32(vf, pf1[s], o1[d]); }
        }
        if (has_next) { *(LAS u32x4*)(lds + AT_K + (buf ^ 1) * 9216 + st_off) = kreg; *(LAS u32x4*)(lds + AT_V + (buf ^ 1) * 9216 + st_off) = vreg; }
        __syncthreads();
        buf ^= 1; kt = nkt;
    }
    l1 += __shfl_xor(l1, 32);
    { const LAS float* row = oacc + (wave * 32 + qrow) * 65;
        l1 += row[64];
        const float inv1 = 1.0f / l1;
        bf16* yrow = Y + tok * DM + ycol + 4 * hh;
#pragma unroll
        for (int d = 0; d < 2; ++d)
#pragma unroll
            for (int g = 0; g < 4; ++g) { const LAS float* rp = row + 32 * d + 8 * g + 4 * hh;
                u32x2 w; w.x = pk2((o1[d][4 * g] + rp[0]) * inv1, (o1[d][4 * g + 1] + rp[1]) * inv1); w.y = pk2((o1[d][4 * g + 2] + rp[2]) * inv1, (o1[d][4 * g + 3] + rp[3]) * inv1);
                *(u32x2*)(yrow + 32 * d + 8 * g) = w; } }
    __syncthreads();
}
__device__ __forceinline__ void attn_c128(const LAS Args& a, int layer, LAS unsigned char* lds, int b, int head, int qt) {
    int tid_ = threadIdx.x; asm volatile("" : "+v"(tid_));
    const int tid = tid_, lane = tid & 63, wave = __builtin_amdgcn_readfirstlane(tid >> 6), map = wave >> 2, wq = wave & 3, qrow = lane & 31, hh = lane >> 5;
    const int q0 = qt * 128, q0w = q0 + wq * 32, qpos = q0w + qrow;
    const size_t tok = (size_t)b * SEQ + qpos;
    const bf16* QKV = (const bf16*)(sptr(a.ws) + WS_QKV); const bf16* VT = (const bf16*)(sptr(a.ws) + WS_VT); bf16* Y = (bf16*)(sptr(a.ws) + WS_H);
    const int qcol = 1536 + head * 64 + 32 * map, kcol = 1792 + head * 64, hv = 6 + head, ycol = 768 + head * 64;
    bf16x8 qf[2];
#pragma unroll
    for (int i = 0; i < 2; ++i) qf[i] = *(const bf16x8*)(QKV + tok * NQKV + qcol + 16 * i + 8 * hh);
    float lam;
    { float t1 = 0.f, t2 = 0.f;
        if (lane < 32) { t1 = sptr(a.in[I_LQ1])[layer * 32 + lane] * sptr(a.in[I_LK1])[layer * 32 + lane]; t2 = sptr(a.in[I_LQ2])[layer * 32 + lane] * sptr(a.in[I_LK2])[layer * 32 + lane]; }
        lam = expf(wave_sum(t1)) - expf(wave_sum(t2)) + a.lam_init[layer]; }
    const int kt_hi = 2 * (qt + 1);
    const int lrow = tid >> 3, lch = tid & 7;
    const bf16* kg = QKV + ((size_t)b * SEQ + lrow) * NQKV + kcol + 8 * lch;
    const bf16* vg = VT + (((size_t)b * 10 + hv) * 64 + lrow) * SEQ + 8 * lch;
    const int st_off = lrow * 144 + lch * 16;
#define LOAD_SET(S, t) do { const int t_ = (t) < kt_hi ? (t) : kt_hi - 1; S##k = *(const u32x4*)(kg + (size_t)(t_ * 64) * NQKV); S##v = *(const u32x4*)(vg + t_ * 64); } while (0)
#define STORE_SET(S, st) do { *(LAS u32x4*)(lds + AT_K + (st) * 9216 + st_off) = S##k; *(LAS u32x4*)(lds + AT_V + (st) * 9216 + st_off) = S##v; } while (0)
    typedef float f32x2v __attribute__((ext_vector_type(2)));
    f32x2v lv = {0.f, 0.f};
    f32x16 o1[2]; float l1 = 0.f;
#pragma unroll
    for (int d = 0; d < 2; ++d)
#pragma unroll
        for (int i = 0; i < 16; ++i) o1[d][i] = 0.f;
#define C_TILE_SLOW(buf, kt) do { \
        _Pragma("unroll 1") for (int sub = 0; sub < 2; ++sub) { \
            const int k0s = (kt) * 64 + 32 * sub; \
            if (k0s > q0w + 31) continue; \
            const bool needmask = k0s + 31 > q0w; \
            f32x16 S1; \
            _Pragma("unroll") for (int i = 0; i < 16; ++i) S1[i] = 0.f; \
            const LAS unsigned char* kb = lds + AT_K + (buf) * 9216 + (32 * sub + qrow) * 144 + map * 64 + hh * 16; \
            _Pragma("unroll") for (int i = 0; i < 2; ++i) { const bf16x8 kf = *(const LAS bf16x8*)(kb + i * 32); S1 = MFMA32(kf, qf[i], S1); } \
            const int dbase = qpos - k0s - 4 * hh; \
            float p1[16]; \
            if (needmask) { _Pragma("unroll") for (int i = 0; i < 16; ++i) { const int ci = (i & 3) + 8 * (i >> 2); float e1 = __builtin_amdgcn_exp2f(S1[i]); e1 = (dbase - ci) >= 0 ? e1 : 0.f; p1[i] = e1; } } \
            else { _Pragma("unroll") for (int i = 0; i < 16; ++i) p1[i] = __builtin_amdgcn_exp2f(S1[i]); } \
            _Pragma("unroll") for (int i = 0; i < 8; ++i) lv += (f32x2v){p1[2 * i], p1[2 * i + 1]}; \
            bf16x8 pf1[2]; \
            _Pragma("unroll") for (int s = 0; s < 2; ++s) pf1[s] = pack8(p1[8 * s], p1[8 * s + 1], p1[8 * s + 2], p1[8 * s + 3], p1[8 * s + 4], p1[8 * s + 5], p1[8 * s + 6], p1[8 * s + 7]); \
            const LAS unsigned char* vb = lds + AT_V + (buf) * 9216 + qrow * 144 + (32 * sub + 8 * hh) * 2; \
            _Pragma("unroll") for (int d = 0; d < 2; ++d) \
                _Pragma("unroll") for (int s = 0; s < 2; ++s) { const bf16x8 vf = *(const LAS bf16x8*)(vb + d * (32 * 144) + s * 32); o1[d] = MFMA32(vf, pf1[s], o1[d]); } \
        } } while (0)
#define C_TILE(buf, kt) do { \
        if ((kt) * 64 + 63 <= q0w) { \
              \
            const LAS unsigned char* kbA = lds + AT_K + (buf) * 9216 + qrow * 144 + map * 64 + hh * 16; \
            const bf16x8 ka0 = *(const LAS bf16x8*)(kbA), ka1 = *(const LAS bf16x8*)(kbA + 32), kb0 = *(const LAS bf16x8*)(kbA + 32 * 144), kb1 = *(const LAS bf16x8*)(kbA + 32 * 144 + 32); \
            f32x16 S0, S1; \
            _Pragma("unroll") for (int i = 0; i < 16; ++i) { S0[i] = 0.f; S1[i] = 0.f; } \
            S0 = MFMA32(ka0, qf[0], S0); S1 = MFMA32(kb0, qf[0], S1); S0 = MFMA32(ka1, qf[1], S0); S1 = MFMA32(kb1, qf[1], S1); \
            const LAS unsigned char* vbA = lds + AT_V + (buf) * 9216 + qrow * 144 + (8 * hh) * 2; \
            bf16x8 vfa[4], vfb[4]; \
            _Pragma("unroll") for (int i = 0; i < 4; ++i) vfa[i] = *(const LAS bf16x8*)(vbA + (i >> 1) * (32 * 144) + (i & 1) * 32); \
            float pa[16], pb[16]; \
            _Pragma("unroll") for (int i = 0; i < 16; ++i) pa[i] = __builtin_amdgcn_exp2f(S0[i]); \
            _Pragma("unroll") for (int i = 0; i < 8; ++i) lv += (f32x2v){pa[2 * i], pa[2 * i + 1]}; \
            bf16x8 pfa[2], pfb[2]; \
            _Pragma("unroll") for (int s = 0; s < 2; ++s) pfa[s] = pack8(pa[8 * s], pa[8 * s + 1], pa[8 * s + 2], pa[8 * s + 3], pa[8 * s + 4], pa[8 * s + 5], pa[8 * s + 6], pa[8 * s + 7]); \
            _Pragma("unroll") for (int i = 0; i < 4; ++i) o1[i >> 1] = MFMA32(vfa[i], pfa[i & 1], o1[i >> 1]); \
            _Pragma("unroll") for (int i = 0; i < 4; ++i) vfb[i] = *(const LAS bf16x8*)(vbA + 64 + (i >> 1) * (32 * 144) + (i & 1) * 32); \
            _Pragma("unroll") for (int i = 0; i < 16; ++i) pb[i] = __builtin_amdgcn_exp2f(S1[i]); \
            _Pragma("unroll") for (int i = 0; i < 8; ++i) lv += (f32x2v){pb[2 * i], pb[2 * i + 1]}; \
            _Pragma("unroll") for (int s = 0; s < 2; ++s) pfb[s] = pack8(pb[8 * s], pb[8 * s + 1], pb[8 * s + 2], pb[8 * s + 3], pb[8 * s + 4], pb[8 * s + 5], pb[8 * s + 6], pb[8 * s + 7]); \
            _Pragma("unroll") for (int i = 0; i < 4; ++i) o1[i >> 1] = MFMA32(vfb[i], pfb[i & 1], o1[i >> 1]); \
        } else C_TILE_SLOW(buf, kt); } while (0)
    u32x4 Ak, Av, Bk, Bv;
    LOAD_SET(A, 0); LOAD_SET(B, 1);
    STORE_SET(A, 0);
    LOAD_SET(A, 2);
    __syncthreads();
    for (int kt = 0; kt < kt_hi; kt += 2) {
        STORE_SET(B, 1); LOAD_SET(B, kt + 3);
        C_TILE(0, kt);
        __syncthreads();
        STORE_SET(A, 0); LOAD_SET(A, kt + 4);
        C_TILE(1, kt + 1);
        __syncthreads();
    }
#undef LOAD_SET
#undef STORE_SET
#undef C_TILE
#undef C_TILE_SLOW
    l1 += lv.x + lv.y;
    l1 += __shfl_xor(l1, 32);
    LAS float* cb = (LAS float*)lds + (size_t)wq * 33 * 64 + lane;
    if (map == 1) {
#pragma unroll
        for (int d = 0; d < 2; ++d)
#pragma unroll
            for (int i = 0; i < 16; ++i) cb[(d * 16 + i) * 64] = o1[d][i];
        cb[32 * 64] = l1;
    }
    __syncthreads();
    if (map == 0) {
        const float inv1 = 1.0f / l1, c2 = lam / cb[32 * 64]; float ss = 0.f;
#pragma unroll
        for (int d = 0; d < 2; ++d)
#pragma unroll
            for (int i = 0; i < 16; ++i) { const float o = o1[d][i] * inv1 - cb[(d * 16 + i) * 64] * c2; o1[d][i] = o; ss += o * o; }
        ss += __shfl_xor(ss, 32);
        const float r = (1.0f - a.lam_init[layer]) / sqrtf(ss * (1.f / 64.f) + 1e-6f);
        const float* sg = sptr(a.in[I_SUBLN]) + layer * 64 + 4 * hh;
        bf16* yrow = Y + tok * DM + ycol + 4 * hh;
#pragma unroll
        for (int d = 0; d < 2; ++d)
#pragma unroll
            for (int g = 0; g < 4; ++g) { const f32x4 gg = *(const f32x4*)(sg + 32 * d + 8 * g);
                u32x2 w; w.x = pk2(o1[d][4 * g] * r * gg.x, o1[d][4 * g + 1] * r * gg.y); w.y = pk2(o1[d][4 * g + 2] * r * gg.z, o1[d][4 * g + 3] * r * gg.w);
                *(u32x2*)(yrow + 32 * d + 8 * g) = w; }
    }
    __syncthreads();
}
__device__ __forceinline__ void attn_swa(const LAS Args& a, int layer, LAS unsigned char* lds, int b, int kvh, int qt) {
    int tid_ = threadIdx.x; asm volatile("" : "+v"(tid_));
    const int tid = tid_, lane = tid & 63, wave = __builtin_amdgcn_readfirstlane(tid >> 6), qrow = lane & 31, hh = lane >> 5;
    const int q0 = qt * 256, q0w = q0 + wave * 32, qpos = q0w + qrow;
    const size_t tok = (size_t)b * SEQ + qpos;
    const bf16* QKV = (const bf16*)(sptr(a.ws) + WS_QKV); const bf16* VT = (const bf16*)(sptr(a.ws) + WS_VT); bf16* Y = (bf16*)(sptr(a.ws) + WS_H);
    const int kcol = 1280 + kvh * 64, hv = 4 + kvh;
    const int kt_lo = q0 >= 128 ? (q0 - 128) / 64 : 0, nt = 4 * (qt + 1) - kt_lo;
    { const int lrow = tid >> 3, lch = tid & 7;
        const bf16* kg = QKV + ((size_t)b * SEQ + lrow) * NQKV + kcol + 8 * lch;
        const bf16* vg = VT + (((size_t)b * 10 + hv) * 64 + lrow) * SEQ + 8 * lch;
        const int st_off = lrow * 144 + lch * 16;
        u32x4 kr[6], vr[6];
#pragma unroll
        for (int t = 0; t < 6; ++t) { const int kt = kt_lo + (t < nt ? t : nt - 1); kr[t] = *(const u32x4*)(kg + (size_t)(kt * 64) * NQKV); vr[t] = *(const u32x4*)(vg + kt * 64); }
#pragma unroll
        for (int t = 0; t < 6; ++t) { *(LAS u32x4*)(lds + t * 18432 + st_off) = kr[t]; *(LAS u32x4*)(lds + t * 18432 + 9216 + st_off) = vr[t]; } }
    __syncthreads();
#pragma unroll 1
    for (int h = 0; h < 4; ++h) {
        const int head = kvh * 4 + h, qcol = 768 + head * 64, ycol = 256 + head * 64;
        bf16x8 qf[4];
#pragma unroll
        for (int i = 0; i < 4; ++i) qf[i] = *(const bf16x8*)(QKV + tok * NQKV + qcol + 16 * i + 8 * hh);
        const float sinkv = __builtin_amdgcn_exp2f(sptr(a.in[I_SINKS])[layer * 8 + head] * 1.44269504f);
        f32x16 o1[2]; float l1 = 0.f;
#pragma unroll
        for (int d = 0; d < 2; ++d)
#pragma unroll
            for (int i = 0; i < 16; ++i) o1[d][i] = 0.f;
#pragma unroll 1
        for (int t = 0; t < nt; ++t) {
            const LAS unsigned char* stg = lds + t * 18432;
#pragma unroll 1
            for (int sub = 0; sub < 2; ++sub) {
                const int k0s = (kt_lo + t) * 64 + 32 * sub;
                if ((k0s > q0w + 31) || (k0s + 31 + 127 < q0w)) continue;
                const bool needmask = !((k0s + 31 <= q0w) && (k0s + 127 >= q0w + 31));
                f32x16 S1;
#pragma unroll
                for (int i = 0; i < 16; ++i) S1[i] = 0.f;
                const LAS unsigned char* kb = stg + (32 * sub + qrow) * 144 + hh * 16;
#pragma unroll
                for (int i = 0; i < 4; ++i) { const bf16x8 kf = *(const LAS bf16x8*)(kb + i * 32); S1 = MFMA32(kf, qf[i], S1); }
                const int dbase = qpos - k0s - 4 * hh;
                float p1[16];
                if (needmask) {
#pragma unroll
                    for (int i = 0; i < 16; ++i) { const int ci = (i & 3) + 8 * (i >> 2); float e1 = __builtin_amdgcn_exp2f(S1[i]); e1 = (unsigned)(dbase - ci) < 128u ? e1 : 0.f; l1 += e1; p1[i] = e1; }
                } else {
#pragma unroll
                    for (int i = 0; i < 16; ++i) { const float e1 = __builtin_amdgcn_exp2f(S1[i]); l1 += e1; p1[i] = e1; } }
                bf16x8 pf1[2];
#pragma unroll
                for (int s = 0; s < 2; ++s) pf1[s] = pack8(p1[8 * s], p1[8 * s + 1], p1[8 * s + 2], p1[8 * s + 3], p1[8 * s + 4], p1[8 * s + 5], p1[8 * s + 6], p1[8 * s + 7]);
                const LAS unsigned char* vb = stg + 9216 + qrow * 144 + (32 * sub + 8 * hh) * 2;
#pragma unroll
                for (int d = 0; d < 2; ++d)
#pragma unroll
                    for (int s = 0; s < 2; ++s) { const bf16x8 vf = *(const LAS bf16x8*)(vb + d * (32 * 144) + s * 32); o1[d] = MFMA32(vf, pf1[s], o1[d]); }
            }
        }
        l1 += __shfl_xor(l1, 32);
        l1 += sinkv;
        const float inv1 = 1.0f / l1;
        bf16* yrow = Y + tok * DM + ycol + 4 * hh;
#pragma unroll
        for (int d = 0; d < 2; ++d)
#pragma unroll
            for (int g = 0; g < 4; ++g) { u32x2 w; w.x = pk2(o1[d][4 * g] * inv1, o1[d][4 * g + 1] * inv1); w.y = pk2(o1[d][4 * g + 2] * inv1, o1[d][4 * g + 3] * inv1);
                *(u32x2*)(yrow + 32 * d + 8 * g) = w; }
    }
    __syncthreads();
}
__device__ __forceinline__ void phase_attn(const LAS Args& a, int layer, LAS unsigned char* lds, int qoff = 0) {
    unsigned* queue = (unsigned*)(sptr(a.ws) + WS_CTL) + 64 * layer + qoff;
    volatile LAS unsigned* misc = (volatile LAS unsigned*)(lds + AT_MISC);
    for (;;) {
        if (threadIdx.x == 0) misc[0] = atomicAdd(queue, 1u);
        __syncthreads();
        const unsigned u = misc[0];
        __syncthreads();
        if (u >= (unsigned)NUNITS) break;
        if (u < 512u) { const int qt = 63 - (int)(u >> 3), r = u & 7; attn_c128(a, layer, lds, r >> 2, r & 3, qt); }
        else if (u < 768u) { const int v = (int)u - 512, qt = 31 - (v >> 3), r = v & 7; if (qt > 5) attn_moba(a, layer, lds, r >> 2, r & 3, qt); else attn_unit<0>(a, layer, lds, r >> 2, r & 3, qt); }
        else { const int v = (int)u - 768, qt = 31 - (v >> 2), r = v & 3; attn_swa(a, layer, lds, r >> 1, r & 1, qt); }
    }
}

__device__ __forceinline__ void unpack8(const u32x4 w, float (&f)[8]) {
    f[0] = pg8::bflo(w.x); f[1] = pg8::bfhi(w.x); f[2] = pg8::bflo(w.y); f[3] = pg8::bfhi(w.y); f[4] = pg8::bflo(w.z); f[5] = pg8::bfhi(w.z); f[6] = pg8::bflo(w.w); f[7] = pg8::bfhi(w.w);
}
__device__ __forceinline__ void phase_conv(const LAS Args& a, int layer) {
    int tid_ = threadIdx.x; asm volatile("" : "+v"(tid_));
    const int tid = tid_;
    if (tid >= FF / 8) return;
    bf16* ACT = (bf16*)(sptr(a.ws) + WS_U); const bf16* HALO = (const bf16*)(sptr(a.ws) + WS_HALO); const bf16* TOP = (const bf16*)(sptr(a.ws) + WS_TOP);
    const int ch0 = tid * 8;
    const float* cw = sptr(a.in[I_CONVW]) + (size_t)layer * 3 * FF2; const float* cb = sptr(a.in[I_CONVB]) + (size_t)layer * FF2;
    float wg[3][8], wv[3][8], bg[8], bv[8];
#pragma unroll
    for (int e = 0; e < 8; ++e) {
#pragma unroll
        for (int j = 0; j < 3; ++j) { wg[j][e] = cw[j * FF2 + ch0 + e]; wv[j][e] = cw[j * FF2 + FF + ch0 + e]; }
        bg[e] = cb[ch0 + e]; bv[e] = cb[FF + ch0 + e]; }
    for (int c = blockIdx.x; c < MTOK / 64; c += gridDim.x) {
        float g2[8], g1[8], v2[8], v1[8];
        if ((c * 64) % SEQ == 0) {
#pragma unroll
            for (int e = 0; e < 8; ++e) { g2[e] = 0.f; g1[e] = 0.f; v2[e] = 0.f; v1[e] = 0.f; }
        } else { const bf16* hp = HALO + (size_t)(c - 1) * 2 * FF2;
            unpack8(*(const u32x4*)(hp + ch0), g2); unpack8(*(const u32x4*)(hp + FF + ch0), v2);
            unpack8(*(const u32x4*)(hp + FF2 + ch0), g1); unpack8(*(const u32x4*)(hp + FF2 + FF + ch0), v1); }
        const bf16* tp = TOP + (size_t)c * 2 * FF2;
#pragma unroll
        for (int r = 0; r < 2; ++r) {
            float g0[8], v0[8], o[8]; unpack8(*(const u32x4*)(tp + (size_t)r * FF2 + ch0), g0); unpack8(*(const u32x4*)(tp + (size_t)r * FF2 + FF + ch0), v0);
#pragma unroll
            for (int e = 0; e < 8; ++e) {
                const float yg = bg[e] + wg[0][e] * g2[e] + wg[1][e] * g1[e] + wg[2][e] * g0[e];
                const float yv = bv[e] + wv[0][e] * v2[e] + wv[1][e] * v1[e] + wv[2][e] * v0[e];
                o[e] = yg * pg8::sigmoidf_(yg) * yv;
                g2[e] = g1[e]; g1[e] = g0[e]; v2[e] = v1[e]; v1[e] = v0[e]; }
            u32x4 w; w.x = pk2(o[0], o[1]); w.y = pk2(o[2], o[3]); w.z = pk2(o[4], o[5]); w.w = pk2(o[6], o[7]);
            *(u32x4*)(ACT + (size_t)(c * 64 + r) * FF + ch0) = w; }
    }
}

#ifndef PHM
#define PHM 0x3ff
#endif
#ifndef REPM
#define REPM 0
#endif
#define IN(k) (lo <= (k) && (k) < hi)
#define XB_TMO      128
#define XB_XCNT(j)  (256  + 64 * (j))
#define XB_XSUB(j)  (1280 + 64 * (j))
#define XB_XGEN(j)  (2304 + 64 * (j))
#define XB_TOP      3328
#define XB_TOPGEN   3392
#define XCD_BAR_WORDS 3456
#define XB_SPIN_CAP (1u << 18)

__device__ __forceinline__ unsigned xb_ld(unsigned* p)              { return __hip_atomic_load(p, __ATOMIC_RELAXED, __HIP_MEMORY_SCOPE_AGENT); }
__device__ __forceinline__ unsigned xb_add(unsigned* p, unsigned v) { return __hip_atomic_fetch_add(p, v, __ATOMIC_RELAXED, __HIP_MEMORY_SCOPE_AGENT); }
__device__ __forceinline__ unsigned xb_xcc_id() { return (unsigned)__builtin_amdgcn_s_getreg((3 << 11) | 20) & 0xFu; }
#define XB_SPIN(cond, bar) do { unsigned _sp = 0; while (cond) { __builtin_amdgcn_s_sleep(1); \
    if ((++_sp & 255u) == 0u) { if (xb_ld(&(bar)[XB_TMO])) break; if (_sp > XB_SPIN_CAP) { atomicAdd(&(bar)[XB_TMO], 1u); break; } } } } while (0)

struct XcdBarrier {
    unsigned* bar; unsigned x;
    volatile LAS unsigned* st;
};

__device__ __forceinline__ XcdBarrier xcd_barrier_post(unsigned* bar, volatile LAS unsigned* st) {
    XcdBarrier b; b.bar = bar; b.x = xb_xcc_id(); b.st = st;
    if (threadIdx.x == 0) (void)xb_add(&bar[XB_XCNT(b.x)], 1u);
    return b;
}
__device__ __forceinline__ void xcd_barrier_complete(unsigned* bar, unsigned x, unsigned& nloc, unsigned& nx) {
    const unsigned G = gridDim.x * gridDim.y * gridDim.z;
    unsigned sum, cnt, mine, sp = 0u;
    for (;;) {
        sum = 0u; cnt = 0u; mine = 0u;
#pragma unroll
        for (unsigned j = 0; j < 16; ++j) { const unsigned c = xb_ld(&bar[XB_XCNT(j)]); sum += c; cnt += (c > 0u) ? 1u : 0u; mine = (j == x) ? c : mine; }
        if (sum == G) break;
        __builtin_amdgcn_s_sleep(1);
        if ((++sp & 255u) == 0u) { if (xb_ld(&bar[XB_TMO])) break; if (sp > XB_SPIN_CAP) { atomicAdd(&bar[XB_TMO], 1u); break; } }
    }
    nloc = mine > 0u ? mine : 1u; nx = cnt > 0u ? cnt : 1u;
}

__device__ __forceinline__ void xcd_barrier(const XcdBarrier& b) {
    asm volatile("s_waitcnt vmcnt(0)" ::: "memory");
    __syncthreads();
    if (threadIdx.x == 0) {
        unsigned* bar = b.bar;
        __builtin_amdgcn_s_waitcnt(0);
        unsigned nloc = b.st[0], nx = b.st[1];
        if (nloc == 0u) { xcd_barrier_complete(bar, b.x, nloc, nx); b.st[0] = nloc; b.st[1] = nx; }
        const unsigned old = xb_add(&bar[XB_XSUB(b.x)], 1u);
        const unsigned gen = old / nloc;
        if (old + 1u == (gen + 1u) * nloc) {
            __builtin_amdgcn_fence(__ATOMIC_RELEASE, "agent");
            asm volatile("s_waitcnt vmcnt(0)" ::: "memory");
            const unsigned og = xb_add(&bar[XB_TOP], 1u);
            const unsigned tg = og / nx;
            if (og + 1u == (tg + 1u) * nx) xb_add(&bar[XB_TOPGEN], 1u);
            else XB_SPIN(xb_ld(&bar[XB_TOPGEN]) == tg, bar);
            __builtin_amdgcn_fence(__ATOMIC_ACQUIRE, "agent");
            xb_add(&bar[XB_XGEN(b.x)], 1u);
            asm volatile("s_waitcnt vmcnt(0)" ::: "memory");
        } else {
            XB_SPIN(xb_ld(&bar[XB_XGEN(b.x)]) == gen, bar);
            __builtin_amdgcn_fence(__ATOMIC_ACQUIRE, "agent");
            asm volatile("s_waitcnt vmcnt(0)" ::: "memory");
        }
    }
    __syncthreads();
}


#ifndef TSEL
#define TSEL -1
#endif
#define SEAM(k) do { if (IN(k) && IN((k) + 1)) xcd_barrier(xbar); if (TSEL >= 0 && threadIdx.x == 0) ((LAS unsigned long long*)(lds + 132096 + 1024))[(k) + 1] = __builtin_amdgcn_s_memrealtime(); } while (0)
template <int L>
__device__ __forceinline__ void layer_prog(const LAS Args& a, LAS unsigned char* lds, const XcdBarrier& xbar, const int lo, const int hi) {
    unsigned char* ws = sptr(a.ws);
    bf16* Wb = (bf16*)(ws + WS_W);
    bf16* H = (bf16*)(ws + WS_H); bf16* G = (bf16*)(ws + WS_G); bf16* QKV = (bf16*)(ws + WS_QKV); bf16* U = (bf16*)(ws + WS_U); bf16* HALO = (bf16*)(ws + WS_HALO);
    const int G_ = gridDim.x, c_ = blockIdx.x;
    constexpr int B0 = 10 * L;
    const float* xin = L == 0 ? sptr(a.in[I_X]) : sptr(a.out);
    if (IN(B0 + 0) && (PHM & 1)) for (int rep = 0; rep < 1 + (REPM & 1); ++rep) { phase_convert(a, L, lds); phase_norm(xin, sptr(a.in[I_ATTN_NORM]) + L * DM, H); }
    SEAM(B0 + 0);
    if (IN(B0 + 1) && (PHM >> 1 & 1)) for (int rep = 0; rep < 1 + (REPM >> 1 & 1); ++rep) { pg8::Gemm g{H, (const bf16*)((char*)Wb + W_IN), MTOK, NIN, DM, DM}; pg8::StaticOrder S; S.init(MTOK, NIN, G_, c_);
        pg8::EpiProj E{QKV, G}; pg8::gemm_phase<pg8::EpiProj, pg8::StaticOrder, true, true>(lds, g, S, E); }
    SEAM(B0 + 1);
    if (IN(B0 + 2) && (PHM >> 2 & 1)) phase_prep(a, L, lds);
    SEAM(B0 + 2);
    if (IN(B0 + 3) && (PHM >> 3 & 1)) { phase_attn(a, L, lds); if (REPM >> 3 & 1) phase_attn(a, L, lds, 32); }
    SEAM(B0 + 3);
    if (IN(B0 + 4) && (PHM >> 4 & 1)) for (int rep = 0; rep < 1 + (REPM >> 4 & 1); ++rep) {
        pg8::StaticOrder S; S.init(MTOK, DM, G_, c_);
        { pg8::Gemm g{H, (const bf16*)((char*)Wb + W_PA), MTOK, DM, 256, DM}; pg8::EpiGate<0> E{G, 0, QKV}; pg8::gemm_phase<pg8::EpiGate<0>, pg8::StaticOrder, true, true>(lds, g, S, E); }
        { pg8::Gemm g{H + 256, (const bf16*)((char*)Wb + W_PB), MTOK, DM, 512, DM}; pg8::EpiGate<1> E{G, 1024, QKV}; pg8::gemm_phase<pg8::EpiGate<1>, pg8::StaticOrder, true, true>(lds, g, S, E); }
        { pg8::Gemm g{H + 768, (const bf16*)((char*)Wb + W_PC), MTOK, DM, 256, DM}; pg8::EpiGate<1> E{G, 2048, QKV}; pg8::gemm_phase<pg8::EpiGate<1>, pg8::StaticOrder, true, true>(lds, g, S, E); }
    }
    SEAM(B0 + 4);
    if (IN(B0 + 5) && (PHM >> 5 & 1)) { pg8::Gemm g{QKV, (const bf16*)((char*)Wb + W_OUT), MTOK, DM, DM, DM}; pg8::StaticOrder S; S.init(MTOK, DM, G_, c_);
        pg8::EpiResid E{xin, sptr(a.out)}; pg8::gemm_phase<pg8::EpiResid, pg8::StaticOrder, true, true>(lds, g, S, E); }
    SEAM(B0 + 5);
    if (IN(B0 + 6) && (PHM >> 6 & 1)) for (int rep = 0; rep < 1 + (REPM >> 6 & 1); ++rep) phase_norm(sptr(a.out), sptr(a.in[I_MLP_NORM]) + L * DM, H);
    SEAM(B0 + 6);
    if (IN(B0 + 7) && (PHM >> 7 & 1)) for (int rep = 0; rep < 1 + (REPM >> 7 & 1); ++rep) { pg8::Gemm g{H, (const bf16*)((char*)Wb + W_UP), MTOK, FF2, DM, DM}; pg8::StaticOrder S; S.init(MTOK, FF2, G_, c_);
        pg8::EpiUpConv E{U, HALO, (bf16*)(ws + WS_TOP), sptr(a.in[I_CONVW]) + (size_t)L * 3 * FF2, sptr(a.in[I_CONVB]) + (size_t)L * FF2};
        pg8::gemm_phase<pg8::EpiUpConv, pg8::StaticOrder, true, true>(lds, g, S, E); }
    SEAM(B0 + 7);
    if (IN(B0 + 8) && (PHM >> 8 & 1)) phase_conv(a, L);
    SEAM(B0 + 8);
    if (IN(B0 + 9) && (PHM >> 9 & 1)) { pg8::Gemm g{U, (const bf16*)((char*)Wb + W_DOWN), MTOK, DM, FF, FF}; pg8::StaticOrder S; S.init(MTOK, DM, G_, c_);
        pg8::EpiResid E{sptr(a.out), sptr(a.out)}; pg8::gemm_phase<pg8::EpiResid, pg8::StaticOrder, true, true>(lds, g, S, E); }
    SEAM(B0 + 9);
}
__global__ void __launch_bounds__(512, 2) mega_fwd(Args a) {
    extern __shared__ __attribute__((aligned(16))) unsigned char lds_raw[];
    LAS unsigned char* lds = (LAS unsigned char*)lds_raw;
    const int lo = a.ph_lo, hi = a.ph_hi;
    LAS Args& la = *(LAS Args*)(lds + 132096);
    if (threadIdx.x == 0) {
#pragma unroll
        for (int i = 0; i < 24; ++i) la.in[i] = a.in[i];
        la.out = a.out; la.ws = a.ws;
#pragma unroll
        for (int i = 0; i < 32; ++i) la.inv64[i] = a.inv64[i];
#pragma unroll
        for (int i = 0; i < 16; ++i) la.inv32[i] = a.inv32[i];
        la.lam_init[0] = a.lam_init[0]; la.lam_init[1] = a.lam_init[1]; la.ph_lo = lo; la.ph_hi = hi;
        ((LAS unsigned*)(lds + 132096 + 512))[0] = 0u; ((LAS unsigned*)(lds + 132096 + 512))[1] = 0u;
    }
    __syncthreads();
    if (hi - lo > 1) cg::this_grid().sync();
    XcdBarrier xbar; xbar.bar = (unsigned*)(a.ws + WS_CTL) + 1024; xbar.x = 0; xbar.st = nullptr;
    if (hi - lo > 1) xbar = xcd_barrier_post((unsigned*)(a.ws + WS_CTL) + 1024, (volatile LAS unsigned*)(lds + 132096 + 512));
    if (TSEL >= 0 && threadIdx.x == 0) ((LAS unsigned long long*)(lds + 132096 + 1024))[0] = __builtin_amdgcn_s_memrealtime();
    layer_prog<0>(la, lds, xbar, lo, hi);
    layer_prog<1>(la, lds, xbar, lo, hi);
    if (TSEL >= 0) { xcd_barrier(xbar); if (blockIdx.x == 0 && threadIdx.x == 0) { LAS unsigned long long* ts = (LAS unsigned long long*)(lds + 132096 + 1024);
        a.out[0] += floorf((float)(ts[TSEL + 1] - ts[TSEL]) * 0.01f * (1.f / 16.f)) * 16.f + 8.f; } }
}

#ifndef MK_MULTI
#define MK_MULTI 0
#endif
extern "C" void kernel_launch(void* const* d_in, const int* in_sizes, int n_in, void* d_out, int out_size, void* d_ws, size_t ws_size, hipStream_t stream) {
    static int grid = 0;
    if (grid == 0) {
        if (n_in != 24 || ws_size < WS_END) { fprintf(stderr, "kernel_launch: unexpected n_in %d / ws %zu\n", n_in, ws_size); grid = -1; return; }
        int dev = 0, cus = 0, per_cu = 0;
        (void)hipGetDevice(&dev); (void)hipDeviceGetAttribute(&cus, hipDeviceAttributeMultiprocessorCount, dev);
        if (hipFuncSetAttribute((const void*)mega_fwd, hipFuncAttributeMaxDynamicSharedMemorySize, LDS_BYTES) != hipSuccess) { fprintf(stderr, "hipFuncSetAttribute failed\n"); grid = -1; return; }
        if (hipOccupancyMaxActiveBlocksPerMultiprocessor(&per_cu, (const void*)mega_fwd, 512, LDS_BYTES) != hipSuccess || per_cu < 1) per_cu = 1;
        (void)hipGetLastError();
        grid = cus * per_cu;
        fprintf(stderr, "kernel_launch: cus %d per_cu %d grid %d\n", cus, per_cu, grid);
    }
    if (grid < 0) return;
    (void)hipMemsetAsync((char*)d_ws + WS_CTL, 0, 32768, stream);
    Args a{};
    for (int i = 0; i < 24; ++i) a.in[i] = (const float*)d_in[i];
    a.out = (float*)d_out; a.ws = (unsigned char*)d_ws;
    for (int i = 0; i < 32; ++i) a.inv64[i] = 1.0f / powf(10000.0f, (float)(2 * i) / 64.0f);
    for (int i = 0; i < 16; ++i) a.inv32[i] = 1.0f / powf(10000.0f, (float)(2 * i) / 32.0f);
    for (int i = 0; i < 2; ++i) a.lam_init[i] = (float)(0.8 - 0.6 * exp(-0.3 * (double)i));
#if MK_MULTI
    for (int ph = 0; ph < NPH; ++ph) { a.ph_lo = ph; a.ph_hi = ph + 1; hipLaunchKernelGGL(mega_fwd, dim3(grid), dim3(512), LDS_BYTES, stream, a); }
#else
    a.ph_lo = 0; a.ph_hi = NPH;
    void* args[] = {&a};
    hipError_t e = hipLaunchCooperativeKernel((const void*)mega_fwd, dim3(grid), dim3(512), args, LDS_BYTES, stream);
    if (e != hipSuccess) fprintf(stderr, "cooperative launch failed: %s (grid %d)\n", hipGetErrorString(e), grid);
#endif
}
```

```cpp
#include <hip/hip_runtime.h>
#include <hip/hip_cooperative_groups.h>
#include <cstdio>
#include <cstdint>
#include <cmath>
namespace cg = cooperative_groups;

namespace pg8 {
#define PG8_LAS __attribute__((address_space(3)))
typedef unsigned short bf16_t;
typedef short bf16x8 __attribute__((ext_vector_type(8)));
typedef float f32x4 __attribute__((ext_vector_type(4)));
typedef unsigned u32x4 __attribute__((ext_vector_type(4)));
constexpr int BM = 256, BK = 64, HALF = 128, HTB = HALF * BK * 2  , STAGE_BYTES = 8 * HTB, NXCD = 8, WGM = 8;

__host__ __device__ __forceinline__ int lds_byte(int r, int c) { const int st = (r >> 4) * 2 + (c >> 5), rr = r & 15, cc = c & 31, ob = rr * 64 + cc * 2; return st * 1024 + (ob ^ (((ob >> 9) & 1) << 5)); }
__host__ __device__ __forceinline__ void stage_rc(int b, int& R, int& C) { const int st = b / 1024, sb = b % 1024, swz = sb ^ (((sb >> 9) & 1) << 5); R = (st >> 1) * 16 + swz / 64; C = (st & 1) * 32 + (swz % 64) / 2; }
__host__ __device__ __forceinline__ int perm32(int rho) { const int n = rho >> 4, i = rho & 15; return 8 * (i >> 2) + 4 * n + (i & 3); }

struct Unit { int pm, pn; };
struct Gemm { const bf16_t* A; const bf16_t* Bt; int M, N, K, lda; };
struct StaticOrder {
    int nM, nN, nwg, G, c;
    __host__ __device__ void init(int M, int N, int G_, int c_) { nM = M / BM; nN = N / BM; nwg = nM * nN; G = G_; c = c_; }
    __host__ __device__ bool next(int i, Unit& u) const {
        const long L = (long)i * G + c; if (L >= nwg) return false;
        int wgid = (int)L; { const int q = nwg / NXCD, r = nwg % NXCD, xcd = wgid % NXCD, off = wgid / NXCD; wgid = (xcd < r ? xcd * (q + 1) : r * (q + 1) + (xcd - r) * q) + off; }
        const int nig = WGM * nN, gid = wgid / nig, fm = gid * WGM, gsz = (nM - fm) < WGM ? (nM - fm) : WGM;
        u.pm = fm + ((wgid % nig) % gsz); u.pn = (wgid % nig) / gsz; return true;
    }
    __device__ __forceinline__ void a_ready(const Unit&) const {}
    __device__ __forceinline__ void done(const Unit&) const {}
};

__device__ __forceinline__ unsigned cvt_pk_bf16(float lo, float hi) { unsigned r; asm volatile("v_cvt_pk_bf16_f32 %0, %1, %2" : "=v"(r) : "v"(lo), "v"(hi)); return r; }
__device__ __forceinline__ float bflo(unsigned w) { return __builtin_bit_cast(float, w << 16); }
__device__ __forceinline__ float bfhi(unsigned w) { return __builtin_bit_cast(float, w & 0xffff0000u); }
__device__ __forceinline__ float sigmoidf_(float v) { return __builtin_amdgcn_rcpf(1.0f + __builtin_amdgcn_exp2f(-1.44269504f * v)); }
struct EpiProj {
    static constexpr bool PERM = true, AFTER_DRAIN = false;
    bf16_t* QKV; bf16_t* G;
    __device__ __forceinline__ void operator()(const f32x4 (&acc)[2][2][4][2], const Unit& u, int wr, int wc, int fr, int fq) const {
        const int row0 = u.pm * BM + wr * 64 + fr; const bool gate = u.pn >= 9;
        bf16_t* base = gate ? G : QKV; const int ldc = gate ? 3072 : 2304; const int col0 = (gate ? (u.pn - 9) : u.pn) * BM + wc * 32 + 8 * fq;
#pragma unroll
        for (int ai = 0; ai < 2; ++ai)
#pragma unroll
            for (int m = 0; m < 4; ++m) { bf16_t* rowp = base + (size_t)(row0 + ai * HALF + m * 16) * ldc + col0;
#pragma unroll
                for (int bj = 0; bj < 2; ++bj) { f32x4 v0 = acc[ai][bj][m][0], v1 = acc[ai][bj][m][1];
                    if (gate) {
#pragma unroll
                        for (int e = 0; e < 4; ++e) { v0[e] = sigmoidf_(v0[e]); v1[e] = sigmoidf_(v1[e]); } }
                    u32x4 w; w.x = cvt_pk_bf16(v0[0], v0[1]); w.y = cvt_pk_bf16(v0[2], v0[3]); w.z = cvt_pk_bf16(v1[0], v1[1]); w.w = cvt_pk_bf16(v1[2], v1[3]);
                    *(u32x4*)(rowp + bj * HALF) = w; } }
    }
};
template <int ACCUM> struct EpiGate {
    static constexpr bool PERM = true, AFTER_DRAIN = false;
    const bf16_t* G; int gcol0; bf16_t* MG;
    __device__ __forceinline__ void operator()(const f32x4 (&acc)[2][2][4][2], const Unit& u, int wr, int wc, int fr, int fq) const {
        const int row0 = u.pm * BM + wr * 64 + fr; const int col0 = u.pn * BM + wc * 32 + 8 * fq;
#pragma unroll
        for (int ai = 0; ai < 2; ++ai)
#pragma unroll
            for (int m = 0; m < 4; ++m) { const size_t r = (size_t)(row0 + ai * HALF + m * 16);
#pragma unroll
                for (int bj = 0; bj < 2; ++bj) { f32x4 v0 = acc[ai][bj][m][0], v1 = acc[ai][bj][m][1];
                    const u32x4 g = *(const u32x4*)(G + r * 3072 + gcol0 + col0 + bj * HALF);
                    v0[0] *= bflo(g.x); v0[1] *= bfhi(g.x); v0[2] *= bflo(g.y); v0[3] *= bfhi(g.y); v1[0] *= bflo(g.z); v1[1] *= bfhi(g.z); v1[2] *= bflo(g.w); v1[3] *= bfhi(g.w);
                    bf16_t* dst = MG + r * 1024 + col0 + bj * HALF;
                    if (ACCUM) { const u32x4 p = *(const u32x4*)dst;
                        v0[0] += bflo(p.x); v0[1] += bfhi(p.x); v0[2] += bflo(p.y); v0[3] += bfhi(p.y); v1[0] += bflo(p.z); v1[1] += bfhi(p.z); v1[2] += bflo(p.w); v1[3] += bfhi(p.w); }
                    u32x4 w; w.x = cvt_pk_bf16(v0[0], v0[1]); w.y = cvt_pk_bf16(v0[2], v0[3]); w.z = cvt_pk_bf16(v1[0], v1[1]); w.w = cvt_pk_bf16(v1[2], v1[3]);
                    *(u32x4*)dst = w; }
                asm volatile("" ::: "memory"); }
    }
};
struct EpiResid {
    static constexpr bool PERM = true, AFTER_DRAIN = false;
    const float* xin; float* out;
    __device__ __forceinline__ void operator()(const f32x4 (&acc)[2][2][4][2], const Unit& u, int wr, int wc, int fr, int fq) const {
        const int row0 = u.pm * BM + wr * 64 + fr; const int col0 = u.pn * BM + wc * 32 + 8 * fq;
#pragma unroll
        for (int ai = 0; ai < 2; ++ai) { asm volatile("" ::: "memory");
#pragma unroll
            for (int m = 0; m < 4; ++m) { const size_t off = (size_t)(row0 + ai * HALF + m * 16) * 1024 + col0;
#pragma unroll
                for (int bj = 0; bj < 2; ++bj) { const float* xi = xin + off + bj * HALF; float* o = out + off + bj * HALF;
                    const f32x4 x0 = *(const f32x4*)xi, x1 = *(const f32x4*)(xi + 4);
                    *(f32x4*)o = x0 + acc[ai][bj][m][0]; *(f32x4*)(o + 4) = x1 + acc[ai][bj][m][1]; } } }
    }
};
template <int CTRL> __device__ __forceinline__ float dpp0(float x) { return __builtin_bit_cast(float, __builtin_amdgcn_update_dpp(0, __builtin_bit_cast(int, x), CTRL, 0xf, 0xf, true)); }
struct EpiUpConv {
    static constexpr bool PERM = true, AFTER_DRAIN = false;
    bf16_t* ACT; bf16_t* HALO; bf16_t* TOP; const float* cw; const float* cb;
    __device__ __forceinline__ void operator()(const f32x4 (&acc)[2][2][4][2], const Unit& u, int wr, int wc, int fr, int fq) const {
        const int row0 = u.pm * BM + wr * 64 + fr; const int ch0 = u.pn * 128 + wc * 32 + 8 * fq;
#pragma unroll
        for (int n = 0; n < 2; ++n) { const int ch = ch0 + 4 * n;
            const f32x4 wg0 = *(const f32x4*)(cw + ch), wg1 = *(const f32x4*)(cw + 5632 + ch), wg2 = *(const f32x4*)(cw + 2 * 5632 + ch), bg = *(const f32x4*)(cb + ch);
            const f32x4 wv0 = *(const f32x4*)(cw + 2816 + ch), wv1 = *(const f32x4*)(cw + 5632 + 2816 + ch), wv2 = *(const f32x4*)(cw + 2 * 5632 + 2816 + ch), bv = *(const f32x4*)(cb + 2816 + ch);
#pragma unroll
            for (int ai = 0; ai < 2; ++ai)
#pragma unroll
                for (int m = 0; m < 4; ++m) { const int row = row0 + ai * HALF + m * 16;
                    const f32x4 g0 = acc[ai][0][m][n], v0 = acc[ai][1][m][n];
                    f32x4 g1, g2, v1, v2;
#pragma unroll
                    for (int e = 0; e < 4; ++e) { g1[e] = dpp0<0x111>(g0[e]); g2[e] = dpp0<0x112>(g0[e]); v1[e] = dpp0<0x111>(v0[e]); v2[e] = dpp0<0x112>(v0[e]); }
                    if (m > 0) { const f32x4 gm = acc[ai][0][m > 0 ? m - 1 : 0][n], vm = acc[ai][1][m > 0 ? m - 1 : 0][n];
#pragma unroll
                        for (int e = 0; e < 4; ++e) { g1[e] += dpp0<0x10F>(gm[e]); g2[e] += dpp0<0x10E>(gm[e]); v1[e] += dpp0<0x10F>(vm[e]); v2[e] += dpp0<0x10E>(vm[e]); } }
                    const f32x4 yg = bg + wg0 * g2 + wg1 * g1 + wg2 * g0, yv = bv + wv0 * v2 + wv1 * v1 + wv2 * v0;
                    f32x4 o;
#pragma unroll
                    for (int e = 0; e < 4; ++e) o[e] = yg[e] * sigmoidf_(yg[e]) * yv[e];
                    typedef unsigned u32x2e __attribute__((ext_vector_type(2)));
                    const bool top = (m == 0) && (fr < 2);
                    if (!top) { u32x2e w; w.x = cvt_pk_bf16(o[0], o[1]); w.y = cvt_pk_bf16(o[2], o[3]); *(u32x2e*)(ACT + (size_t)row * 2816 + ch) = w; }
                    if (top || (m == 3 && fr >= 14)) { bf16_t* sp = (top ? TOP + ((size_t)(row >> 6) * 2 + fr) * 5632 : HALO + ((size_t)(row >> 6) * 2 + (fr - 14)) * 5632) + ch;
                        u32x2e wgr, wvr; wgr.x = cvt_pk_bf16(g0[0], g0[1]); wgr.y = cvt_pk_bf16(g0[2], g0[3]); wvr.x = cvt_pk_bf16(v0[0], v0[1]); wvr.y = cvt_pk_bf16(v0[2], v0[3]);
                        *(u32x2e*)sp = wgr; *(u32x2e*)(sp + 2816) = wvr; } }
        }
    }
};
struct EpiUp {
    static constexpr bool PERM = true, AFTER_DRAIN = false;
    bf16_t* U; bf16_t* HALO;
    __device__ __forceinline__ void operator()(const f32x4 (&acc)[2][2][4][2], const Unit& u, int wr, int wc, int fr, int fq) const {
        const int row0 = u.pm * BM + wr * 64 + fr; const int col0 = u.pn * BM + wc * 32 + 8 * fq;
#pragma unroll
        for (int ai = 0; ai < 2; ++ai)
#pragma unroll
            for (int m = 0; m < 4; ++m) { const int row = row0 + ai * HALF + m * 16; bf16_t* rowp = U + (size_t)row * 5632 + col0;
#pragma unroll
                for (int bj = 0; bj < 2; ++bj) { const f32x4 v0 = acc[ai][bj][m][0], v1 = acc[ai][bj][m][1];
                    u32x4 w; w.x = cvt_pk_bf16(v0[0], v0[1]); w.y = cvt_pk_bf16(v0[2], v0[3]); w.z = cvt_pk_bf16(v1[0], v1[1]); w.w = cvt_pk_bf16(v1[2], v1[3]);
                    *(u32x4*)(rowp + bj * HALF) = w;
                    if (m == 3 && fr >= 14) *(u32x4*)(HALO + ((size_t)(row >> 6) * 2 + (fr - 14)) * 5632 + col0 + bj * HALF) = w; } }
    }
};

template <class Epi, class Sched, bool ALIGN_EPI = false, bool SP2 = false>
__device__ __forceinline__ void gemm_phase(PG8_LAS unsigned char* lds, const Gemm g, const Sched& S, const Epi& E) {
    int tid_ = threadIdx.x; asm volatile("" : "+v"(tid_));
    const int tid = tid_, wid = __builtin_amdgcn_readfirstlane(tid >> 6), lane = tid & 63, wr = wid >> 2, wc = wid & 3, fr = lane & 15, fq = lane >> 4;
    const int K = g.K, nt = K / BK;
    unsigned voffA[2], voffB[2];
#pragma unroll
    for (int i = 0; i < 2; ++i) { int R, C; stage_rc(tid * 16 + i * 8192, R, C); const int Rb = Epi::PERM ? ((R & ~31) + perm32(R & 31)) : R;
        voffA[i] = (unsigned)(R * g.lda + C) * 2u; voffB[i] = (unsigned)(Rb * K + C) * 2u; }
    const size_t kstep = (size_t)(BK * 2);
    const size_t hstepA = (size_t)HALF * g.lda * 2, hstepB = (size_t)HALF * K * 2;
    const size_t tstepA = 2 * hstepA, tstepB = 2 * hstepB;
    const unsigned ldsw = (unsigned)wid * 1024u;
    const int aoff = lds_byte(wr * 64 + fr, fq * 8), boff = lds_byte(wc * 32 + fr, fq * 8);
#define PG8_SA(b, h) (((b) * 2 + (h)) * HTB)
#define PG8_SB(b, h) ((4 + (b) * 2 + (h)) * HTB)
#define PG8_STAGE(bufoff, gbase, voff) do { _Pragma("unroll") for (int _i = 0; _i < 2; ++_i) \
        __builtin_amdgcn_global_load_lds((const unsigned*)((const char*)(gbase) + (voff)[_i]), (PG8_LAS unsigned*)(lds + (bufoff) + ldsw + _i * 8192), 16, 0, 0); } while (0)
#define PG8_LDA(dst, b, h) do { _Pragma("unroll") for (int m = 0; m < 4; ++m) _Pragma("unroll") for (int k = 0; k < 2; ++k) dst[m][k] = *(const PG8_LAS bf16x8*)(lds + PG8_SA(b, h) + aoff + m * 2048 + k * 1024); } while (0)
#define PG8_LDB(dst, b, h) do { _Pragma("unroll") for (int n = 0; n < 2; ++n) _Pragma("unroll") for (int k = 0; k < 2; ++k) dst[n][k] = *(const PG8_LAS bf16x8*)(lds + PG8_SB(b, h) + boff + n * 2048 + k * 1024); } while (0)
#define PG8_MMA(ai, bj, At, Bt) do { __builtin_amdgcn_s_setprio(1); _Pragma("unroll") for (int m = 0; m < 4; ++m) _Pragma("unroll") for (int n = 0; n < 2; ++n) _Pragma("unroll") for (int k = 0; k < 2; ++k) \
        acc[ai][bj][m][n] = __builtin_amdgcn_mfma_f32_16x16x32_bf16(Bt[n][k], At[m][k], acc[ai][bj][m][n], 0, 0, 0); __builtin_amdgcn_s_setprio(0); } while (0)
#define PG8_WAIT_V(n) asm volatile("s_waitcnt vmcnt(" #n ")" ::: "memory")
#define PG8_WAIT_L(n) asm volatile("s_waitcnt lgkmcnt(" #n ")" ::: "memory")
#define PG8_BAR __builtin_amdgcn_s_barrier()
#define PG8_SCHED __builtin_amdgcn_sched_barrier(0)
    Unit cur, nxt; int ui = 0;
    if (!S.next(0, cur)) return;
    f32x4 acc[2][2][4][2];
#pragma unroll
    for (int a = 0; a < 2; ++a)
#pragma unroll
        for (int b = 0; b < 2; ++b)
#pragma unroll
            for (int m = 0; m < 4; ++m)
#pragma unroll
                for (int n = 0; n < 2; ++n) acc[a][b][m][n] = (f32x4){0.f, 0.f, 0.f, 0.f};
    bf16x8 At[4][2], B0[2][2], B1[2][2];
    const char* cA = (const char*)g.A + (size_t)cur.pm * tstepA; const char* cB = (const char*)g.Bt + (size_t)cur.pn * tstepB;
    S.a_ready(cur);
    if constexpr (SP2) {
        PG8_STAGE(PG8_SB(0, 0), cB, voffB); PG8_STAGE(PG8_SB(0, 1), cB + hstepB, voffB); PG8_STAGE(PG8_SA(0, 0), cA, voffA); PG8_STAGE(PG8_SA(0, 1), cA + hstepA, voffA);
        if (wr == 1) PG8_BAR;
        PG8_WAIT_V(2); PG8_BAR;
        PG8_STAGE(PG8_SB(1, 0), cB + kstep, voffB); PG8_STAGE(PG8_SA(1, 0), cA + kstep, voffA); PG8_STAGE(PG8_SB(1, 1), cB + hstepB + kstep, voffB);
        PG8_WAIT_V(6); PG8_BAR;
    } else {
        PG8_STAGE(PG8_SB(0, 0), cB, voffB); PG8_STAGE(PG8_SA(0, 0), cA, voffA); PG8_STAGE(PG8_SB(0, 1), cB + hstepB, voffB); PG8_STAGE(PG8_SA(0, 1), cA + hstepA, voffA);
        if (wr == 1) PG8_BAR;
        PG8_WAIT_V(4); PG8_BAR;
        PG8_STAGE(PG8_SB(1, 0), cB + kstep, voffB); PG8_STAGE(PG8_SA(1, 0), cA + kstep, voffA); PG8_STAGE(PG8_SB(1, 1), cB + hstepB + kstep, voffB);
        PG8_WAIT_V(6); PG8_BAR;
    }
    for (;;) {
        const bool has_next = S.next(ui + 1, nxt);
        const char* nA = has_next ? (const char*)g.A + (size_t)nxt.pm * tstepA : cA; const char* nB = has_next ? (const char*)g.Bt + (size_t)nxt.pn * tstepB : cB;
        for (int t = 0; t < nt; t += 2) {
            const bool last = (t == nt - 2);
            const char* a1 = cA + (size_t)(t + 1) * kstep;
            const char* a2 = last ? nA : cA + (size_t)(t + 2) * kstep; const char* b2 = last ? nB : cB + (size_t)(t + 2) * kstep;
            const char* a3 = a2 + kstep; const char* b3 = b2 + kstep;
            if (last && has_next) S.a_ready(nxt);
            if constexpr (SP2) {
            PG8_LDB(B0, 0, 0); PG8_LDB(B1, 0, 1); PG8_SCHED; PG8_LDA(At, 0, 0); PG8_STAGE(PG8_SA(1, 1), a1 + hstepA, voffA);
            PG8_WAIT_V(8); PG8_WAIT_L(0); PG8_BAR; PG8_MMA(0, 0, At, B0); PG8_MMA(0, 1, At, B1); PG8_BAR; PG8_SCHED;
            PG8_LDA(At, 0, 1); PG8_STAGE(PG8_SB(0, 0), b2, voffB); PG8_STAGE(PG8_SB(0, 1), b2 + hstepB, voffB); PG8_STAGE(PG8_SA(0, 0), a2, voffA);
            PG8_WAIT_V(8); PG8_WAIT_L(0); PG8_BAR; PG8_MMA(1, 0, At, B0); PG8_MMA(1, 1, At, B1); PG8_BAR; PG8_SCHED;
            PG8_LDB(B0, 1, 0); PG8_LDB(B1, 1, 1); PG8_SCHED; PG8_LDA(At, 1, 0); PG8_STAGE(PG8_SA(0, 1), a2 + hstepA, voffA);
            PG8_WAIT_V(8); PG8_WAIT_L(0); PG8_BAR; PG8_MMA(0, 0, At, B0); PG8_MMA(0, 1, At, B1); PG8_BAR; PG8_SCHED;
            PG8_LDA(At, 1, 1); PG8_STAGE(PG8_SB(1, 0), b3, voffB); PG8_STAGE(PG8_SB(1, 1), b3 + hstepB, voffB); PG8_STAGE(PG8_SA(1, 0), a3, voffA);
            PG8_WAIT_V(8); PG8_WAIT_L(0); PG8_BAR; PG8_MMA(1, 0, At, B0); PG8_MMA(1, 1, At, B1); PG8_BAR; PG8_SCHED;
            } else {
            PG8_LDB(B0, 0, 0); PG8_SCHED; PG8_LDA(At, 0, 0); PG8_STAGE(PG8_SA(1, 1), a1 + hstepA, voffA);
            PG8_WAIT_L(8); PG8_BAR; PG8_WAIT_L(0); PG8_MMA(0, 0, At, B0); PG8_BAR; PG8_SCHED;
            PG8_LDB(B1, 0, 1); PG8_STAGE(PG8_SB(0, 0), b2, voffB);
            PG8_BAR; PG8_WAIT_L(0); PG8_MMA(0, 1, At, B1); PG8_BAR;
            PG8_LDA(At, 0, 1); PG8_STAGE(PG8_SA(0, 0), a2, voffA);
            PG8_BAR; PG8_WAIT_L(0); PG8_MMA(1, 0, At, B0); PG8_BAR; PG8_SCHED;
            PG8_STAGE(PG8_SB(0, 1), b2 + hstepB, voffB);
            PG8_WAIT_V(6); PG8_BAR; PG8_MMA(1, 1, At, B1); PG8_BAR;
            PG8_LDB(B0, 1, 0); PG8_SCHED; PG8_LDA(At, 1, 0); PG8_STAGE(PG8_SA(0, 1), a2 + hstepA, voffA);
            PG8_WAIT_L(8); PG8_BAR; PG8_WAIT_L(0); PG8_MMA(0, 0, At, B0); PG8_BAR; PG8_SCHED;
            PG8_LDB(B1, 1, 1); PG8_STAGE(PG8_SB(1, 0), b3, voffB);
            PG8_BAR; PG8_WAIT_L(0); PG8_MMA(0, 1, At, B1); PG8_BAR;
            PG8_LDA(At, 1, 1); PG8_STAGE(PG8_SA(1, 0), a3, voffA);
            PG8_BAR; PG8_WAIT_L(0); PG8_MMA(1, 0, At, B0); PG8_BAR; PG8_SCHED;
            PG8_STAGE(PG8_SB(1, 1), b3 + hstepB, voffB);
            PG8_WAIT_V(6); PG8_BAR; PG8_MMA(1, 1, At, B1); PG8_BAR;
            }
        }
        if constexpr (ALIGN_EPI) { if (wr == 0) PG8_BAR; }
        if constexpr (!Epi::AFTER_DRAIN) { E(acc, cur, wr, wc, fr, fq); S.done(cur); }
        if (!has_next) break;
#pragma unroll
        for (int a = 0; a < 2; ++a)
#pragma unroll
            for (int b = 0; b < 2; ++b)
#pragma unroll
                for (int m = 0; m < 4; ++m)
#pragma unroll
                    for (int n = 0; n < 2; ++n) acc[a][b][m][n] = (f32x4){0.f, 0.f, 0.f, 0.f};
        cur = nxt; cA = nA; cB = nB; ++ui;
        if constexpr (ALIGN_EPI) { if (wr == 1) PG8_BAR; }
    }
    PG8_WAIT_V(0);
    if constexpr (!ALIGN_EPI) { if (wr == 0) PG8_BAR; }
    PG8_BAR;
    if constexpr (Epi::AFTER_DRAIN) { E.fused(acc, cur, wr, wc, fr, fq, lds, wid, lane); S.done(cur); }
#undef PG8_SA
#undef PG8_SB
#undef PG8_STAGE
#undef PG8_LDA
#undef PG8_LDB
#undef PG8_MMA
#undef PG8_WAIT_V
#undef PG8_WAIT_L
#undef PG8_BAR
#undef PG8_SCHED
}
}

#define LAS __attribute__((address_space(3)))
typedef unsigned short bf16;
typedef short bf16x8 __attribute__((ext_vector_type(8)));
typedef float f32x4 __attribute__((ext_vector_type(4)));
typedef float f32x16 __attribute__((ext_vector_type(16)));
typedef unsigned u32x4 __attribute__((ext_vector_type(4)));
typedef unsigned u32x2 __attribute__((ext_vector_type(2)));
constexpr int SEQ = 8192, MTOK = 16384, DM = 1024, NIN = 5376, NQKV = 2304, NGATE = 3072, FF = 2816, FF2 = 5632;
constexpr size_t MiB = 1u << 20;
constexpr size_t WS_CTL = 0, WS_KMP = 64 * 1024;
constexpr size_t WS_W = 1 * MiB;
constexpr size_t W_IN = 0, W_PA = W_IN + (size_t)NIN * DM * 2, W_PB = W_PA + 1024 * 256 * 2, W_PC = W_PB + 1024 * 512 * 2, W_OUT = W_PC + 1024 * 256 * 2,
                 W_UP = W_OUT + 1024 * 1024 * 2, W_DOWN = W_UP + (size_t)FF2 * DM * 2, W_END = W_DOWN + (size_t)DM * FF * 2;
static_assert(W_END <= 31 * MiB, "weights");
constexpr size_t WS_H = 32 * MiB;
constexpr size_t WS_G = 64 * MiB;
constexpr size_t WS_QKV = 160 * MiB;
constexpr size_t WS_VT = 232 * MiB;
constexpr size_t WS_U = 64 * MiB;
constexpr size_t WS_HALO = 240 * MiB;
constexpr size_t WS_TOP = 246 * MiB;
constexpr size_t WS_END = 252 * MiB;
constexpr int LDS_BYTES = 147456;
constexpr int NPH = 20;

struct Args {
    const float* in[24]; float* out; unsigned char* ws;
    float inv64[32]; float inv32[16]; float lam_init[2];
    int ph_lo, ph_hi;
};
enum { I_X = 0, I_ATTN_NORM, I_W_IN, I_QN_A, I_KN_A, I_QN_B, I_KN_B, I_SINKS, I_QN_C, I_KN_C, I_LQ1, I_LK1, I_LQ2, I_LK2, I_SUBLN, I_WPA, I_WPB, I_WPC, I_WOUT, I_MLP_NORM, I_WUP, I_CONVW, I_CONVB, I_WDOWN };

template <class T> __device__ __forceinline__ T* sptr(T* p) { const unsigned long long v = (unsigned long long)p;
    const unsigned lo = __builtin_amdgcn_readfirstlane((unsigned)v), hi = __builtin_amdgcn_readfirstlane((unsigned)(v >> 32));
    return (T*)(__attribute__((address_space(1))) T*)(((unsigned long long)hi << 32) | lo); }

__device__ __forceinline__ unsigned f2bf(float f) { unsigned u = __builtin_bit_cast(unsigned, f); return (u + 0x7fffu + ((u >> 16) & 1u)) >> 16; }
__device__ __forceinline__ unsigned pk2(float lo, float hi) { return pg8::cvt_pk_bf16(lo, hi); }
__device__ __forceinline__ float bf2f(unsigned short v) { return __builtin_bit_cast(float, (unsigned)v << 16); }
__device__ __forceinline__ float wave_sum(float v) {
#pragma unroll
    for (int o = 1; o < 64; o <<= 1) v += __shfl_xor(v, o);
    return v;
}
#define LDS_WAIT() asm volatile("s_waitcnt lgkmcnt(0)" ::: "memory")

__device__ __forceinline__ void transpose_item(const float* W, int K, int N, bf16* WT, LAS float* scr, int item, int lane, bool pair = false) {
    const int nblk = N / 32, kb = item / nblk, nb = item % nblk, k0 = 64 * kb, n0 = 32 * nb;
#pragma unroll
    for (int i = 0; i < 32; ++i) { const int kk = 2 * i + (lane >> 5); scr[kk * 33 + (lane & 31)] = W[(size_t)(k0 + kk) * N + n0 + (lane & 31)]; }
    LDS_WAIT(); asm volatile("" ::: "memory");
    const int c = lane & 7;
#pragma unroll
    for (int j = 0; j < 4; ++j) { const int n = (lane >> 3) + 8 * j; const LAS float* s = scr + (8 * c) * 33 + n;
        u32x4 o; o.x = pk2(s[0 * 33], s[1 * 33]); o.y = pk2(s[2 * 33], s[3 * 33]); o.z = pk2(s[4 * 33], s[5 * 33]); o.w = pk2(s[6 * 33], s[7 * 33]);
        int nr = n0 + n; if (pair) { const int isv = nr >= FF ? 1 : 0, chn = nr - isv * FF; nr = 256 * (chn >> 7) + 128 * isv + (chn & 127); }
        *(u32x4*)(WT + (size_t)nr * K + k0 + 8 * c) = o; }
    LDS_WAIT(); asm volatile("" ::: "memory");
}
__device__ __forceinline__ void rms_row_to_bf16(const float* xrow, const float* gain, bf16* orow, int lane) {
    const f32x4* xr = (const f32x4*)xrow + lane; const f32x4* gr = (const f32x4*)gain + lane;
    f32x4 v[4]; float s = 0.f;
#pragma unroll
    for (int j = 0; j < 4; ++j) { v[j] = xr[64 * j]; s += (v[j].x * v[j].x + v[j].y * v[j].y) + (v[j].z * v[j].z + v[j].w * v[j].w); }
    const float rinv = 1.0f / sqrtf(wave_sum(s) * (1.f / DM) + 1e-6f);
    unsigned long long* o8 = (unsigned long long*)orow + lane;
#pragma unroll
    for (int j = 0; j < 4; ++j) { const f32x4 g = gr[64 * j];
        o8[64 * j] = (unsigned long long)pk2(v[j].x * rinv * g.x, v[j].y * rinv * g.y) | ((unsigned long long)pk2(v[j].z * rinv * g.z, v[j].w * rinv * g.w) << 32); }
}

__device__ __forceinline__ void phase_convert(const LAS Args& a, int layer, LAS unsigned char* lds) {
    int tid_ = threadIdx.x; asm volatile("" : "+v"(tid_));
    const int lane = tid_ & 63, wave = tid_ >> 6, gw = blockIdx.x * 8 + wave, NGW = gridDim.x * 8;
    LAS float* scr = (LAS float*)(lds + wave * 16384);
    bf16* Wb = (bf16*)(sptr(a.ws) + WS_W);
    constexpr int I0 = 16 * (NIN / 32), I1 = 4 * 32, I2 = 8 * 32, I3 = 4 * 32, I4 = 16 * 32, I5 = 16 * (FF2 / 32), I6 = (FF / 64) * 32;
    constexpr int NIT = I0 + I1 + I2 + I3 + I4 + I5 + I6;
    for (int it = gw; it < NIT; it += NGW) {
        int r = it;
        if (r < I0) { transpose_item(sptr(a.in[I_W_IN]) + (size_t)layer * DM * NIN, DM, NIN, (bf16*)((char*)Wb + W_IN), scr, r, lane); continue; } r -= I0;
        if (r < I1) { transpose_item(sptr(a.in[I_WPA]) + (size_t)layer * 256 * DM, 256, DM, (bf16*)((char*)Wb + W_PA), scr, r, lane); continue; } r -= I1;
        if (r < I2) { transpose_item(sptr(a.in[I_WPB]) + (size_t)layer * 512 * DM, 512, DM, (bf16*)((char*)Wb + W_PB), scr, r, lane); continue; } r -= I2;
        if (r < I3) { transpose_item(sptr(a.in[I_WPC]) + (size_t)layer * 256 * DM, 256, DM, (bf16*)((char*)Wb + W_PC), scr, r, lane); continue; } r -= I3;
        if (r < I4) { transpose_item(sptr(a.in[I_WOUT]) + (size_t)layer * DM * DM, DM, DM, (bf16*)((char*)Wb + W_OUT), scr, r, lane); continue; } r -= I4;
        if (r < I5) { transpose_item(sptr(a.in[I_WUP]) + (size_t)layer * DM * FF2, DM, FF2, (bf16*)((char*)Wb + W_UP), scr, r, lane, true); continue; } r -= I5;
        transpose_item(sptr(a.in[I_WDOWN]) + (size_t)layer * FF * DM, FF, DM, (bf16*)((char*)Wb + W_DOWN), scr, r, lane);
    }
}
__device__ __forceinline__ void phase_norm(const float* x, const float* gain, bf16* H) {
    int tid_ = threadIdx.x; asm volatile("" : "+v"(tid_));
    const int lane = tid_ & 63, wave = tid_ >> 6, gw = blockIdx.x * 8 + wave, NGW = gridDim.x * 8;
    const f32x4* gr = (const f32x4*)gain + lane;
    f32x4 g4[4];
#pragma unroll
    for (int j = 0; j < 4; ++j) g4[j] = gr[64 * j];
    int m = gw;
    f32x4 vn[4];
    if (m < MTOK) { const f32x4* xr = (const f32x4*)(x + (size_t)m * DM) + lane;
#pragma unroll
        for (int j = 0; j < 4; ++j) vn[j] = xr[64 * j]; }
    for (; m < MTOK; m += NGW) {
        f32x4 v[4];
#pragma unroll
        for (int j = 0; j < 4; ++j) v[j] = vn[j];
        if (m + NGW < MTOK) { const f32x4* xr = (const f32x4*)(x + (size_t)(m + NGW) * DM) + lane;
#pragma unroll
            for (int j = 0; j < 4; ++j) vn[j] = xr[64 * j]; }
        float s = 0.f;
#pragma unroll
        for (int j = 0; j < 4; ++j) s += (v[j].x * v[j].x + v[j].y * v[j].y) + (v[j].z * v[j].z + v[j].w * v[j].w);
        const float rinv = 1.0f / sqrtf(wave_sum(s) * (1.f / DM) + 1e-6f);
        unsigned long long* o8 = (unsigned long long*)(H + (size_t)m * DM) + lane;
#pragma unroll
        for (int j = 0; j < 4; ++j) o8[64 * j] = (unsigned long long)pk2(v[j].x * rinv * g4[j].x, v[j].y * rinv * g4[j].y) | ((unsigned long long)pk2(v[j].z * rinv * g4[j].z, v[j].w * rinv * g4[j].w) << 32);
    }
}

template <int CTRL> __device__ __forceinline__ float dppf(float x) { return __builtin_bit_cast(float, __builtin_amdgcn_mov_dpp(__builtin_bit_cast(int, x), CTRL, 0xf, 0xf, true)); }
__device__ __forceinline__ float row16_sum(float x) { x += dppf<0xB1>(x); x += dppf<0x4E>(x); x += dppf<0x141>(x); x += dppf<0x128>(x); return x; }
__device__ __forceinline__ void sincos_rev(float ang, float& s, float& c) {
    const float k = rintf(ang * 0.15915494309f);
    float r = fmaf(-k, 6.28125f, ang); r = fmaf(-k, 1.9353071795864769e-3f, r);
    const float f = r * 0.15915494309f;
    s = __builtin_amdgcn_sinf(f); c = __builtin_amdgcn_cosf(f);
}
__device__ __forceinline__ void phase_prep(const LAS Args& a, int layer, LAS unsigned char* lds) {
    int tid_ = threadIdx.x; asm volatile("" : "+v"(tid_));
    const int tid = tid_, lane = tid & 63, wave = tid >> 6;
    bf16* QKV = (bf16*)(sptr(a.ws) + WS_QKV); bf16* VT = (bf16*)(sptr(a.ws) + WS_VT); float* KMP = (float*)(sptr(a.ws) + WS_KMP);
    LAS unsigned short* vt = (LAS unsigned short*)lds;
    LAS float* kms = (LAS float*)(lds + 10 * 64 * 68 * 2);
    const float gqa = sptr(a.in[I_QN_A])[layer * 64 + lane], gka = sptr(a.in[I_KN_A])[layer * 64 + lane], gqb = sptr(a.in[I_QN_B])[layer * 64 + lane], gkb = sptr(a.in[I_KN_B])[layer * 64 + lane];
    const float gqc = sptr(a.in[I_QN_C])[layer * 32 + (lane & 31)], gkc = sptr(a.in[I_KN_C])[layer * 32 + (lane & 31)];
    const float iv64 = a.inv64[lane & 31], iv32 = a.inv32[lane & 15];
    const float sg64 = (lane & 32) ? 1.f : -1.f, sg32 = (lane & 16) ? 1.f : -1.f;
    const float QS64 = 0.125f * 1.44269504f, QS32 = 0.17677669529f * 1.44269504f;
    for (int c = blockIdx.x; c < MTOK / 64; c += gridDim.x) {
        const int tb = 64 * c, b = tb / SEQ, spos0 = tb % SEQ;
        float kacc[4] = {0.f, 0.f, 0.f, 0.f};
        unsigned short vn[36];
        { const bf16* r0 = QKV + (size_t)(tb + wave * 8) * NQKV;
#pragma unroll
            for (int s = 0; s < 36; ++s) vn[s] = r0[64 * s + lane]; }
#pragma unroll 1
        for (int i = 0; i < 8; ++i) {
            const int p64 = wave * 8 + i, tok = tb + p64, pos = spos0 + p64;
            bf16* row = QKV + (size_t)tok * NQKV;
            float v[36];
#pragma unroll
            for (int s = 0; s < 36; ++s) v[s] = bf2f(vn[s]);
            if (i < 7) { const bf16* rn = row + NQKV;
#pragma unroll
                for (int s = 0; s < 36; ++s) vn[s] = rn[64 * s + lane]; }
            float s64, c64, s32, c32; sincos_rev((float)pos * iv64, s64, c64); sincos_rev((float)pos * iv32, s32, c32);
            s64 *= sg64; s32 *= sg32;
            const int k16 = p64 & 15, ppos = (p64 & ~15) | (8 * ((k16 >> 2) & 1) + 4 * ((k16 >> 3) & 1) + (k16 & 3));
#pragma unroll
            for (int s = 0; s < 36; ++s) {
                const bool isv = (s >= 8 && s < 12) || (s >= 22 && s < 24) || (s >= 32);
                if (isv) { const int hv = s < 12 ? s - 8 : (s < 24 ? 4 + s - 22 : 6 + s - 32); vt[(hv * 64 + lane) * 68 + ppos] = (unsigned short)f2bf(v[s]); continue; }
                const bool isc = s >= 24;
                float x = v[s], ss = x * x;
                ss = row16_sum(ss); ss += __shfl_xor(ss, 16);
                if (!isc) ss += __shfl_xor(ss, 32);
                const float rinv = 1.0f / sqrtf(ss * (isc ? (1.f / 32.f) : (1.f / 64.f)) + 1e-6f);
                float g, qs = 1.f;
                if (s < 4) { g = gqa; qs = QS64; } else if (s < 8) g = gka; else if (s < 20) { g = gqb; qs = QS64; } else if (s < 22) g = gkb; else if (s < 28) { g = gqc; qs = QS32; } else g = gkc;
                x = x * rinv * g;
                const float partner = __shfl_xor(x, isc ? 16 : 32);
                const float y = isc ? (x * c32 + partner * s32) : (x * c64 + partner * s64);
                if (s >= 4 && s < 8) kacc[s - 4] += y;
                row[64 * s + lane] = (unsigned short)f2bf(y * qs);
            }
        }
#pragma unroll
        for (int h = 0; h < 4; ++h) kms[(wave * 4 + h) * 64 + lane] = kacc[h];
        __syncthreads();
        if (tid < 256) { float s = 0.f;
#pragma unroll
            for (int w = 0; w < 8; ++w) s += kms[w * 256 + tid];
            KMP[(size_t)c * 256 + tid] = s; }
#pragma unroll
        for (int j = 0; j < 10; ++j) { const int idx = tid + 512 * j, r = idx >> 3, ch = idx & 7, hv = r >> 6, dv = r & 63;
            const LAS u32x2* src = (const LAS u32x2*)(lds + (size_t)r * 136 + ch * 16);
            const u32x2 lo = src[0], hi = src[1]; u32x4 o; o.x = lo.x; o.y = lo.y; o.z = hi.x; o.w = hi.y;
            *(u32x4*)(VT + (((size_t)b * 10 + hv) * 64 + dv) * SEQ + spos0 + 8 * ch) = o; }
        __syncthreads();
    }
}

#ifndef ATM
#define ATM 7
#endif
#define MFMA32(a, b, c) __builtin_amdgcn_mfma_f32_32x32x16_bf16((a), (b), (c), 0, 0, 0)
__device__ __forceinline__ bf16x8 pack8(float p0, float p1, float p2, float p3, float p4, float p5, float p6, float p7) {
    u32x4 p;
    asm volatile("v_cvt_pk_bf16_f32 %0, %4, %5\n\tv_cvt_pk_bf16_f32 %1, %6, %7\n\tv_cvt_pk_bf16_f32 %2, %8, %9\n\tv_cvt_pk_bf16_f32 %3, %10, %11\n\ts_nop 1"
                 : "=&v"(p[0]), "=&v"(p[1]), "=&v"(p[2]), "=&v"(p[3]) : "v"(p0), "v"(p1), "v"(p2), "v"(p3), "v"(p4), "v"(p5), "v"(p6), "v"(p7));
    return __builtin_bit_cast(bf16x8, p);
}
constexpr int AT_K = 0, AT_V = 18432, AT_KM = 36864, AT_MISC = 45056;
constexpr int NUNITS = 896;

template <int MODE>
__device__ __forceinline__ void attn_unit(const LAS Args& a, int layer, LAS unsigned char* lds, int b, int head, int qt) {
    int tid_ = threadIdx.x; asm volatile("" : "+v"(tid_));
    const int tid = tid_, lane = tid & 63, wave = __builtin_amdgcn_readfirstlane(tid >> 6), qrow = lane & 31, hh = lane >> 5;
    const int q0 = qt * 256, q0w = q0 + wave * 32, qpos = q0w + qrow;
    const size_t tok = (size_t)b * SEQ + qpos;
    const bf16* QKV = (const bf16*)(sptr(a.ws) + WS_QKV); const bf16* VT = (const bf16*)(sptr(a.ws) + WS_VT); bf16* Y = (bf16*)(sptr(a.ws) + WS_H);
    const int qcol = MODE == 0 ? head * 64 : (MODE == 1 ? 768 + head * 64 : 1536 + head * 64);
    const int kcol = MODE == 0 ? 256 + head * 64 : (MODE == 1 ? 1280 + (head >> 2) * 64 : 1792 + head * 64);
    const int hv = MODE == 0 ? head : (MODE == 1 ? 4 + (head >> 2) : 6 + head);
    const int ycol = MODE == 0 ? head * 64 : (MODE == 1 ? 256 + head * 64 : 768 + head * 64);
    volatile LAS unsigned* misc = (volatile LAS unsigned*)(lds + AT_MISC);
    bf16x8 qf[4];
#pragma unroll
    for (int i = 0; i < 4; ++i) qf[i] = *(const bf16x8*)(QKV + tok * NQKV + qcol + 16 * i + 8 * hh);
    unsigned mymask = 0u, umask = 0u;
    if (MODE == 0) {
        if (qt <= 3) { mymask = (1u << qt) - 1u; umask = mymask; }
        else {
            LAS float* kml = (LAS float*)(lds + AT_KM);
            const float* KMP = (const float*)(sptr(a.ws) + WS_KMP);
            for (int idx = tid; idx < qt * 64; idx += 512) { const int j = idx >> 6, d = idx & 63; const float* p = KMP + ((size_t)(b * 128 + 4 * j) * 4 + head) * 64 + d;
                kml[idx] = (p[0] + p[256] + p[512] + p[768]) * (1.f / 256.f); }
            if (tid == 0) misc[2] = 0u;
            __syncthreads();
            float qv[32];
#pragma unroll
            for (int i = 0; i < 4; ++i) { const u32x4 w = *(const u32x4*)(QKV + tok * NQKV + qcol + 32 * hh + 8 * i);
                qv[8 * i + 0] = pg8::bflo(w.x); qv[8 * i + 1] = pg8::bfhi(w.x); qv[8 * i + 2] = pg8::bflo(w.y); qv[8 * i + 3] = pg8::bfhi(w.y);
                qv[8 * i + 4] = pg8::bflo(w.z); qv[8 * i + 5] = pg8::bfhi(w.z); qv[8 * i + 6] = pg8::bflo(w.w); qv[8 * i + 7] = pg8::bfhi(w.w); }
            float v0 = -INFINITY, v1 = -INFINITY, v2 = -INFINITY; int i0 = 0, i1 = 0, i2 = 0;
            for (int j = 0; j < qt; ++j) {
                const LAS f32x4* kr = (const LAS f32x4*)(kml + j * 64 + 32 * hh);
                float acc = 0.f;
#pragma unroll
                for (int i = 0; i < 8; ++i) { const f32x4 kk = kr[i]; acc += qv[4 * i] * kk.x + qv[4 * i + 1] * kk.y + qv[4 * i + 2] * kk.z + qv[4 * i + 3] * kk.w; }
                const float g = acc + __shfl_xor(acc, 32);
                if (g > v0) { v2 = v1; i2 = i1; v1 = v0; i1 = i0; v0 = g; i0 = j; }
                else if (g > v1) { v2 = v1; i2 = i1; v1 = g; i1 = j; }
                else if (g > v2) { v2 = g; i2 = j; }
            }
            mymask = (1u << i0) | (1u << i1) | (1u << i2);
            atomicOr((unsigned*)(lds + AT_MISC) + 2, mymask);
            __syncthreads();
            umask = misc[2];
        }
    }
    float lam = 0.f, sinkv = 0.f;
    if (MODE == 2) { float t1 = 0.f, t2 = 0.f;
        if (lane < 32) { t1 = sptr(a.in[I_LQ1])[layer * 32 + lane] * sptr(a.in[I_LK1])[layer * 32 + lane]; t2 = sptr(a.in[I_LQ2])[layer * 32 + lane] * sptr(a.in[I_LK2])[layer * 32 + lane]; }
        lam = expf(wave_sum(t1)) - expf(wave_sum(t2)) + a.lam_init[layer]; }
    if (MODE == 1) sinkv = __builtin_amdgcn_exp2f(sptr(a.in[I_SINKS])[layer * 8 + head] * 1.44269504f);

    const int kt_hi = 4 * (qt + 1);
    int kt = 0;
    if (MODE == 1) kt = q0 >= 128 ? (q0 - 128) / 64 : 0;
#define VALID_TILE(t) (MODE != 0 || ((t) >> 2) == qt || ((umask >> ((t) >> 2)) & 1u))
    while (!VALID_TILE(kt)) ++kt;
    const int lrow = tid >> 3, lch = tid & 7;
    const bf16* kg = QKV + ((size_t)b * SEQ + lrow) * NQKV + kcol + 8 * lch;
    const bf16* vg = VT + (((size_t)b * 10 + hv) * 64 + lrow) * SEQ + 8 * lch;
    const int st_off = lrow * 144 + lch * 16;
    u32x4 kreg = *(const u32x4*)(kg + (size_t)(kt * 64) * NQKV), vreg = *(const u32x4*)(vg + kt * 64);
    *(LAS u32x4*)(lds + AT_K + st_off) = kreg; *(LAS u32x4*)(lds + AT_V + st_off) = vreg;
    __syncthreads();
    f32x16 o1[2], o2[2]; float l1 = 0.f, l2 = 0.f;
#pragma unroll
    for (int d = 0; d < 2; ++d)
#pragma unroll
        for (int i = 0; i < 16; ++i) { o1[d][i] = 0.f; o2[d][i] = 0.f; }
    int buf = 0;
    while (kt < kt_hi) {
        int nkt = kt + 1;
        while (nkt < kt_hi && !VALID_TILE(nkt)) ++nkt;
        const bool has_next = nkt < kt_hi;
        if (has_next) { kreg = *(const u32x4*)(kg + (size_t)(nkt * 64) * NQKV); vreg = *(const u32x4*)(vg + nkt * 64); }
#pragma unroll 1
        for (int sub = 0; sub < 2; ++sub) {
            const int k0s = kt * 64 + 32 * sub;
            bool skip, needmask = false, past = false; unsigned uwin = 0x7fffffffu; bool bit = true;
            if (MODE == 1) { skip = (k0s > q0w + 31) || (k0s + 31 + 127 < q0w); needmask = !((k0s + 31 <= q0w) && (k0s + 127 >= q0w + 31)); uwin = 128u; }
            else if (MODE == 0 && (kt >> 2) != qt) { past = true; bit = (mymask >> (kt >> 2)) & 1u; skip = (__ballot(bit) == 0ull); }
            else { skip = k0s > q0w + 31; needmask = k0s + 31 > q0w; }
            if (skip) continue;
            f32x16 S1, S2;
#pragma unroll
            for (int i = 0; i < 16; ++i) { S1[i] = 0.f; S2[i] = 0.f; }
            const LAS unsigned char* kb = lds + AT_K + buf * 9216 + (32 * sub + qrow) * 144 + hh * 16;
#pragma unroll
            for (int i = 0; i < 4; ++i) { const bf16x8 kf = *(const LAS bf16x8*)(kb + i * 32);
                if (MODE == 2 && i >= 2) S2 = MFMA32(kf, qf[i], S2); else S1 = MFMA32(kf, qf[i], S1); }
            const int dbase = qpos - k0s - 4 * hh;
            float p1[16], p2[16];
#define EXPL(MASKED) _Pragma("unroll") for (int i = 0; i < 16; ++i) { \
                const int ci = (i & 3) + 8 * (i >> 2); \
                float e1 = __builtin_amdgcn_exp2f(S1[i]), e2 = 0.f; \
                if (MODE == 2) e2 = __builtin_amdgcn_exp2f(S2[i]); \
                if (MASKED) { const bool ok = past ? bit : ((unsigned)(dbase - ci) < uwin); e1 = ok ? e1 : 0.f; e2 = ok ? e2 : 0.f; } \
                l1 += e1; p1[i] = e1; \
                if (MODE == 2) { l2 += e2; p2[i] = e2; } }
            if (needmask || past) { EXPL(true) } else { EXPL(false) }
#undef EXPL
            bf16x8 pf1[2], pf2[2];
#pragma unroll
            for (int s = 0; s < 2; ++s) { pf1[s] = pack8(p1[8 * s], p1[8 * s + 1], p1[8 * s + 2], p1[8 * s + 3], p1[8 * s + 4], p1[8 * s + 5], p1[8 * s + 6], p1[8 * s + 7]);
                if (MODE == 2) pf2[s] = pack8(p2[8 * s], p2[8 * s + 1], p2[8 * s + 2], p2[8 * s + 3], p2[8 * s + 4], p2[8 * s + 5], p2[8 * s + 6], p2[8 * s + 7]); }
            const LAS unsigned char* vb = lds + AT_V + buf * 9216 + qrow * 144 + (32 * sub + 8 * hh) * 2;
#pragma unroll
            for (int d = 0; d < 2; ++d)
#pragma unroll
                for (int s = 0; s < 2; ++s) { const bf16x8 vf = *(const LAS bf16x8*)(vb + d * (32 * 144) + s * 32);
                    o1[d] = MFMA32(vf, pf1[s], o1[d]);
                    if (MODE == 2) o2[d] = MFMA32(vf, pf2[s], o2[d]); }
        }
        if (has_next) { *(LAS u32x4*)(lds + AT_K + (buf ^ 1) * 9216 + st_off) = kreg; *(LAS u32x4*)(lds + AT_V + (buf ^ 1) * 9216 + st_off) = vreg; }
        __syncthreads();
        buf ^= 1; kt = nkt;
    }
#undef VALID_TILE
    l1 += __shfl_xor(l1, 32);
    if (MODE == 1) l1 += sinkv;
    const float inv1 = 1.0f / l1;
    bf16* yrow = Y + tok * DM + ycol + 4 * hh;
    if (MODE != 2) {
#pragma unroll
        for (int d = 0; d < 2; ++d)
#pragma unroll
            for (int g = 0; g < 4; ++g) { u32x2 w; w.x = pk2(o1[d][4 * g] * inv1, o1[d][4 * g + 1] * inv1); w.y = pk2(o1[d][4 * g + 2] * inv1, o1[d][4 * g + 3] * inv1);
                *(u32x2*)(yrow + 32 * d + 8 * g) = w; }
    } else {
        l2 += __shfl_xor(l2, 32);
        const float c2 = lam / l2; float ss = 0.f;
#pragma unroll
        for (int d = 0; d < 2; ++d)
#pragma unroll
            for (int i = 0; i < 16; ++i) { const float o = o1[d][i] * inv1 - o2[d][i] * c2; o1[d][i] = o; ss += o * o; }
        ss += __shfl_xor(ss, 32);
        const float r = (1.0f - a.lam_init[layer]) / sqrtf(ss * (1.f / 64.f) + 1e-6f);
        const float* sg = sptr(a.in[I_SUBLN]) + layer * 64 + 4 * hh;
#pragma unroll
        for (int d = 0; d < 2; ++d)
#pragma unroll
            for (int g = 0; g < 4; ++g) { const f32x4 gg = *(const f32x4*)(sg + 32 * d + 8 * g);
                u32x2 w; w.x = pk2(o1[d][4 * g] * r * gg.x, o1[d][4 * g + 1] * r * gg.y); w.y = pk2(o1[d][4 * g + 2] * r * gg.z, o1[d][4 * g + 3] * r * gg.w);
                *(u32x2*)(yrow + 32 * d + 8 * g) = w; }
    }
}
constexpr int MO_OACC = 46080, MO_IDX = 112640, MO_CNTW = 120832, MO_TOT = 121856, MO_TASKS = 121984;
__device__ __forceinline__ void attn_moba(const LAS Args& a, int layer, LAS unsigned char* lds, int b, int head, int qt) {
    int tid_ = threadIdx.x; asm volatile("" : "+v"(tid_));
    const int tid = tid_, lane = tid & 63, wave = __builtin_amdgcn_readfirstlane(tid >> 6), qrow = lane & 31, hh = lane >> 5;
    const int q0 = qt * 256, q0w = q0 + wave * 32, qpos = q0w + qrow, own = qt;
    const size_t tok = (size_t)b * SEQ + qpos;
    const bf16* QKV = (const bf16*)(sptr(a.ws) + WS_QKV); const bf16* VT = (const bf16*)(sptr(a.ws) + WS_VT); bf16* Y = (bf16*)(sptr(a.ws) + WS_H);
    const int qcol = head * 64, kcol = 256 + head * 64, hv = head, ycol = head * 64;
    volatile LAS unsigned* misc = (volatile LAS unsigned*)(lds + AT_MISC);
    LAS float* oacc = (LAS float*)(lds + MO_OACC);
    LAS unsigned char* idxl = (LAS unsigned char*)(lds + MO_IDX);
    LAS unsigned* cntw = (LAS unsigned*)(lds + MO_CNTW);
    LAS unsigned* tot = (LAS unsigned*)(lds + MO_TOT);
    LAS unsigned short* tasks = (LAS unsigned short*)(lds + MO_TASKS);
    unsigned mymask = 0u;
    if (own <= 3) mymask = (1u << own) - 1u;
    else {
        LAS float* kml = (LAS float*)(lds + AT_KM);
        const float* KMP = (const float*)(sptr(a.ws) + WS_KMP);
        for (int idx = tid; idx < own * 64; idx += 512) { const int j = idx >> 6, d = idx & 63; const float* p = KMP + ((size_t)(b * 128 + 4 * j) * 4 + head) * 64 + d;
            kml[idx] = (p[0] + p[256] + p[512] + p[768]) * (1.f / 256.f); }
        __syncthreads();
        float qv[32];
#pragma unroll
        for (int i = 0; i < 4; ++i) { const u32x4 w = *(const u32x4*)(QKV + tok * NQKV + qcol + 32 * hh + 8 * i);
            qv[8 * i + 0] = pg8::bflo(w.x); qv[8 * i + 1] = pg8::bfhi(w.x); qv[8 * i + 2] = pg8::bflo(w.y); qv[8 * i + 3] = pg8::bfhi(w.y);
            qv[8 * i + 4] = pg8::bflo(w.z); qv[8 * i + 5] = pg8::bfhi(w.z); qv[8 * i + 6] = pg8::bflo(w.w); qv[8 * i + 7] = pg8::bfhi(w.w); }
        float v0 = -INFINITY, v1 = -INFINITY, v2 = -INFINITY; int i0 = 0, i1 = 0, i2 = 0;
        for (int j = 0; j < own; ++j) {
            const LAS f32x4* kr = (const LAS f32x4*)(kml + j * 64 + 32 * hh);
            float acc = 0.f;
#pragma unroll
            for (int i = 0; i < 8; ++i) { const f32x4 kk = kr[i]; acc += qv[4 * i] * kk.x + qv[4 * i + 1] * kk.y + qv[4 * i + 2] * kk.z + qv[4 * i + 3] * kk.w; }
            const float g = acc + __shfl_xor(acc, 32);
            if (g > v0) { v2 = v1; i2 = i1; v1 = v0; i1 = i0; v0 = g; i0 = j; }
            else if (g > v1) { v2 = v1; i2 = i1; v1 = g; i1 = j; }
            else if (g > v2) { v2 = g; i2 = j; }
        }
        mymask = (1u << i0) | (1u << i1) | (1u << i2);
    }
    for (int i = tid; i < 256 * 65; i += 512) oacc[i] = 0.f;
    for (int j = 0; j < own; ++j) { const unsigned long long bal = __ballot(((mymask >> j) & 1u) && hh == 0);
        if (lane == 0) cntw[j * 8 + wave] = (unsigned)__popcll(bal); }
    __syncthreads();
    for (int j = 0; j < own; ++j) { const bool sel = ((mymask >> j) & 1u) && hh == 0; const unsigned long long bal = __ballot(sel);
        unsigned base = 0u;
        for (int w = 0; w < wave; ++w) base += cntw[j * 8 + w];
        const unsigned pos = base + (unsigned)__popcll(bal & ((1ull << lane) - 1ull));
        if (sel) idxl[j * 256 + pos] = (unsigned char)(wave * 32 + qrow);
        if (wave == 7 && lane == 0) tot[j] = base + (unsigned)__popcll(bal); }
    __syncthreads();
    if (tid == 0) { unsigned n = 0u;
        for (int j = 0; j < own; ++j) { const unsigned nch = (tot[j] + 31u) >> 5; for (unsigned c = 0; c < nch; ++c) tasks[n++] = (unsigned short)(j | (c << 8)); }
        misc[3] = n; }
    __syncthreads();
    const int ntasks = (int)misc[3];
    for (int t = wave; t < ntasks; t += 8) {
        const unsigned tk = tasks[t]; const int j = tk & 255, c = tk >> 8; const int tj = (int)tot[j];
        const int slot = 32 * c + qrow; const bool valid = slot < tj;
        const int qi = idxl[j * 256 + (valid ? slot : 32 * c)];
        const bf16* qp = QKV + ((size_t)b * SEQ + q0 + qi) * NQKV + qcol + 8 * hh;
        bf16x8 qg[4];
#pragma unroll
        for (int i = 0; i < 4; ++i) qg[i] = *(const bf16x8*)(qp + 16 * i);
        const bf16* kcoal = QKV + ((size_t)b * SEQ + 256 * j + (lane >> 3)) * NQKV + kcol + 8 * (lane & 7);
        LAS unsigned char* kst = lds + wave * 4608;
        const int kst_w = (lane >> 3) * 144 + (lane & 7) * 16, kst_r = qrow * 144 + hh * 16;
        const bf16* vbase = VT + (((size_t)b * 10 + hv) * 64 + qrow) * SEQ + 256 * j + 8 * hh;
        f32x16 og[2]; float lg = 0.f;
#pragma unroll
        for (int d = 0; d < 2; ++d)
#pragma unroll
            for (int i = 0; i < 16; ++i) og[d][i] = 0.f;
        u32x4 kc[4]; bf16x8 vc[4];
#pragma unroll
        for (int i = 0; i < 4; ++i) { kc[i] = *(const u32x4*)(kcoal + (size_t)(8 * i) * NQKV); vc[i] = *(const bf16x8*)(vbase + (size_t)(i >> 1) * 32 * SEQ + 16 * (i & 1)); }
#pragma unroll 4
        for (int sub = 0; sub < 8; ++sub) {
#pragma unroll
            for (int i = 0; i < 4; ++i) *(LAS u32x4*)(kst + kst_w + i * (8 * 144)) = kc[i];
            u32x4 kn[4]; bf16x8 vn[4];
            if (sub < 7) {
#pragma unroll
                for (int i = 0; i < 4; ++i) { kn[i] = *(const u32x4*)(kcoal + (size_t)(32 * (sub + 1) + 8 * i) * NQKV);
                    vn[i] = *(const bf16x8*)(vbase + (size_t)(i >> 1) * 32 * SEQ + 32 * (sub + 1) + 16 * (i & 1)); } }
            f32x16 S;
#pragma unroll
            for (int i = 0; i < 16; ++i) S[i] = 0.f;
#pragma unroll
            for (int i = 0; i < 4; ++i) { const bf16x8 kf = *(const LAS bf16x8*)(kst + kst_r + i * 32); S = MFMA32(kf, qg[i], S); }
            float p[16];
#pragma unroll
            for (int i = 0; i < 16; ++i) { p[i] = __builtin_amdgcn_exp2f(S[i]); lg += p[i]; }
            bf16x8 pf[2];
#pragma unroll
            for (int s = 0; s < 2; ++s) pf[s] = pack8(p[8 * s], p[8 * s + 1], p[8 * s + 2], p[8 * s + 3], p[8 * s + 4], p[8 * s + 5], p[8 * s + 6], p[8 * s + 7]);
#pragma unroll
            for (int i = 0; i < 4; ++i) og[i >> 1] = MFMA32(vc[i], pf[i & 1], og[i >> 1]);
            if (sub < 7) {
#pragma unroll
                for (int i = 0; i < 4; ++i) { kc[i] = kn[i]; vc[i] = vn[i]; } }
        }
        if (valid) { LAS float* row = oacc + qi * 65;
#pragma unroll
            for (int d = 0; d < 2; ++d)
#pragma unroll
                for (int i = 0; i < 16; ++i) (void)__hip_atomic_fetch_add(row + 32 * d + (i & 3) + 8 * (i >> 2) + 4 * hh, og[d][i], __ATOMIC_RELAXED, __HIP_MEMORY_SCOPE_WORKGROUP);
            (void)__hip_atomic_fetch_add(row + 64, lg, __ATOMIC_RELAXED, __HIP_MEMORY_SCOPE_WORKGROUP); }
    }
    bf16x8 qf[4];
#pragma unroll
    for (int i = 0; i < 4; ++i) qf[i] = *(const bf16x8*)(QKV + tok * NQKV + qcol + 16 * i + 8 * hh);
    const int lrow = tid >> 3, lch = tid & 7;
    const bf16* kg = QKV + ((size_t)b * SEQ + lrow) * NQKV + kcol + 8 * lch;
    const bf16* vg = VT + (((size_t)b * 10 + hv) * 64 + lrow) * SEQ + 8 * lch;
    const int st_off = lrow * 144 + lch * 16;
    int kt = 4 * own; const int kt_hi = 4 * own + 4;
    u32x4 kreg = *(const u32x4*)(kg + (size_t)(kt * 64) * NQKV), vreg = *(const u32x4*)(vg + kt * 64);
    __syncthreads();
    *(LAS u32x4*)(lds + AT_K + st_off) = kreg; *(LAS u32x4*)(lds + AT_V + st_off) = vreg;
    __syncthreads();
    f32x16 o1[2]; float l1 = 0.f;
#pragma unroll
    for (int d = 0; d < 2; ++d)
#pragma unroll
        for (int i = 0; i < 16; ++i) o1[d][i] = 0.f;
    int buf = 0;
    while (kt < kt_hi) {
        const int nkt = kt + 1; const bool has_next = nkt < kt_hi;
        if (has_next) { kreg = *(const u32x4*)(kg + (size_t)(nkt * 64) * NQKV); vreg = *(const u32x4*)(vg + nkt * 64); }
#pragma unroll 1
        for (int sub = 0; sub < 2; ++sub) {
            const int k0s = kt * 64 + 32 * sub;
            if (k0s > q0w + 31) continue;
            const bool needmask = k0s + 31 > q0w;
            f32x16 S1;
#pragma unroll
            for (int i = 0; i < 16; ++i) S1[i] = 0.f;
            const LAS unsigned char* kb = lds + AT_K + buf * 9216 + (32 * sub + qrow) * 144 + hh * 16;
#pragma unroll
            for (int i = 0; i < 4; ++i) { const bf16x8 kf = *(const LAS bf16x8*)(kb + i * 32); S1 = MFMA32(kf, qf[i], S1); }
            const int dbase = qpos - k0s - 4 * hh;
            float p1[16];
#define EXPL(MASKED) _Pragma("unroll") for (int i = 0; i < 16; ++i) { \
                const int ci = (i & 3) + 8 * (i >> 2); \
                float e1 = __builtin_amdgcn_exp2f(S1[i]); \
                if (MASKED) e1 = (dbase - ci) >= 0 ? e1 : 0.f; \
                l1 += e1; p1[i] = e1; }
            if (needmask) { EXPL(true) } else { EXPL(false) }
#undef EXPL
            bf16x8 pf1[2];
#pragma unroll
            for (int s = 0; s < 2; ++s) pf1[s] = pack8(p1[8 * s], p1[8 * s + 1], p1[8 * s + 2], p1[8 * s + 3], p1[8 * s + 4], p1[8 * s + 5], p1[8 * s + 6], p1[8 * s + 7]);
            const LAS unsigned char* vb = lds + AT_V + buf * 9216 + qrow * 144 + (32 * sub + 8 * hh) * 2;
#pragma unroll
            for (int d = 0; d < 2; ++d)
#pragma unroll
                for (int s = 0; s < 2; ++s) { const bf16x8 vf = *(const LAS bf16x8*)(vb + d * (32 * 144) + s * 32); o1[d] = MFMA32(vf, pf1[s], o1[d]); }
        }
        if (has_next) { *(LAS u32x4*)(lds + AT_K + (buf ^ 1) * 9216 + st_off) = kreg; *(LAS u32x4*)(lds + AT_V + (buf ^ 1) * 9216 + st_off) = vreg; }
        __syncthreads();
        buf ^= 1; kt = nkt;
    }
    l1 += __shfl_xor(l1, 32);
    { const LAS float* row = oacc + (wave * 32 + qrow) * 65;
        l1 += row[64];
        const float inv1 = 1.0f / l1;
        bf16* yrow = Y + tok * DM + ycol + 4 * hh;
#pragma unroll
        for (int d = 0; d < 2; ++d)
#pragma unroll
            for (int g = 0; g < 4; ++g) { const LAS float* rp = row + 32 * d + 8 * g + 4 * hh;
                u32x2 w; w.x = pk2((o1[d][4 * g] + rp[0]) * inv1, (o1[d][4 * g + 1] + rp[1]) * inv1); w.y = pk2((o1[d][4 * g + 2] + rp[2]) * inv1, (o1[d][4 * g + 3] + rp[3]) * inv1);
                *(u32x2*)(yrow + 32 * d + 8 * g) = w; } }
    __syncthreads();
}
__device__ __forceinline__ void attn_c128(const LAS Args& a, int layer, LAS unsigned char* lds, int b, int head, int qt) {
    int tid_ = threadIdx.x; asm volatile("" : "+v"(tid_));
    const int tid = tid_, lane = tid & 63, wave = __builtin_amdgcn_readfirstlane(tid >> 6), map = wave >> 2, wq = wave & 3, qrow = lane & 31, hh = lane >> 5;
    const int q0 = qt * 128, q0w = q0 + wq * 32, qpos = q0w + qrow;
    const size_t tok = (size_t)b * SEQ + qpos;
    const bf16* QKV = (const bf16*)(sptr(a.ws) + WS_QKV); const bf16* VT = (const bf16*)(sptr(a.ws) + WS_VT); bf16* Y = (bf16*)(sptr(a.ws) + WS_H);
    const int qcol = 1536 + head * 64 + 32 * map, kcol = 1792 + head * 64, hv = 6 + head, ycol = 768 + head * 64;
    bf16x8 qf[2];
#pragma unroll
    for (int i = 0; i < 2; ++i) qf[i] = *(const bf16x8*)(QKV + tok * NQKV + qcol + 16 * i + 8 * hh);
    float lam;
    { float t1 = 0.f, t2 = 0.f;
        if (lane < 32) { t1 = sptr(a.in[I_LQ1])[layer * 32 + lane] * sptr(a.in[I_LK1])[layer * 32 + lane]; t2 = sptr(a.in[I_LQ2])[layer * 32 + lane] * sptr(a.in[I_LK2])[layer * 32 + lane]; }
        lam = expf(wave_sum(t1)) - expf(wave_sum(t2)) + a.lam_init[layer]; }
    const int kt_hi = 2 * (qt + 1);
    const int lrow = tid >> 3, lch = tid & 7;
    const bf16* kg = QKV + ((size_t)b * SEQ + lrow) * NQKV + kcol + 8 * lch;
    const bf16* vg = VT + (((size_t)b * 10 + hv) * 64 + lrow) * SEQ + 8 * lch;
    const int st_off = lrow * 144 + lch * 16;
#define LOAD_SET(S, t) do { const int t_ = (t) < kt_hi ? (t) : kt_hi - 1; S##k = *(const u32x4*)(kg + (size_t)(t_ * 64) * NQKV); S##v = *(const u32x4*)(vg + t_ * 64); } while (0)
#define STORE_SET(S, st) do { *(LAS u32x4*)(lds + AT_K + (st) * 9216 + st_off) = S##k; *(LAS u32x4*)(lds + AT_V + (st) * 9216 + st_off) = S##v; } while (0)
    typedef float f32x2v __attribute__((ext_vector_type(2)));
    f32x2v lv = {0.f, 0.f};
    f32x16 o1[2]; float l1 = 0.f;
#pragma unroll
    for (int d = 0; d < 2; ++d)
#pragma unroll
        for (int i = 0; i < 16; ++i) o1[d][i] = 0.f;
#define C_TILE_SLOW(buf, kt) do { \
        _Pragma("unroll 1") for (int sub = 0; sub < 2; ++sub) { \
            const int k0s = (kt) * 64 + 32 * sub; \
            if (k0s > q0w + 31) continue; \
            const bool needmask = k0s + 31 > q0w; \
            f32x16 S1; \
            _Pragma("unroll") for (int i = 0; i < 16; ++i) S1[i] = 0.f; \
            const LAS unsigned char* kb = lds + AT_K + (buf) * 9216 + (32 * sub + qrow) * 144 + map * 64 + hh * 16; \
            _Pragma("unroll") for (int i = 0; i < 2; ++i) { const bf16x8 kf = *(const LAS bf16x8*)(kb + i * 32); S1 = MFMA32(kf, qf[i], S1); } \
            const int dbase = qpos - k0s - 4 * hh; \
            float p1[16]; \
            if (needmask) { _Pragma("unroll") for (int i = 0; i < 16; ++i) { const int ci = (i & 3) + 8 * (i >> 2); float e1 = __builtin_amdgcn_exp2f(S1[i]); e1 = (dbase - ci) >= 0 ? e1 : 0.f; p1[i] = e1; } } \
            else { _Pragma("unroll") for (int i = 0; i < 16; ++i) p1[i] = __builtin_amdgcn_exp2f(S1[i]); } \
            _Pragma("unroll") for (int i = 0; i < 8; ++i) lv += (f32x2v){p1[2 * i], p1[2 * i + 1]}; \
            bf16x8 pf1[2]; \
            _Pragma("unroll") for (int s = 0; s < 2; ++s) pf1[s] = pack8(p1[8 * s], p1[8 * s + 1], p1[8 * s + 2], p1[8 * s + 3], p1[8 * s + 4], p1[8 * s + 5], p1[8 * s + 6], p1[8 * s + 7]); \
            const LAS unsigned char* vb = lds + AT_V + (buf) * 9216 + qrow * 144 + (32 * sub + 8 * hh) * 2; \
            _Pragma("unroll") for (int d = 0; d < 2; ++d) \
                _Pragma("unroll") for (int s = 0; s < 2; ++s) { const bf16x8 vf = *(const LAS bf16x8*)(vb + d * (32 * 144) + s * 32); o1[d] = MFMA32(vf, pf1[s], o1[d]); } \
        } } while (0)
#define C_TILE(buf, kt) do { \
        if ((kt) * 64 + 63 <= q0w) { \
              \
            const LAS unsigned char* kbA = lds + AT_K + (buf) * 9216 + qrow * 144 + map * 64 + hh * 16; \
            const bf16x8 ka0 = *(const LAS bf16x8*)(kbA), ka1 = *(const LAS bf16x8*)(kbA + 32), kb0 = *(const LAS bf16x8*)(kbA + 32 * 144), kb1 = *(const LAS bf16x8*)(kbA + 32 * 144 + 32); \
            f32x16 S0, S1; \
            _Pragma("unroll") for (int i = 0; i < 16; ++i) { S0[i] = 0.f; S1[i] = 0.f; } \
            S0 = MFMA32(ka0, qf[0], S0); S1 = MFMA32(kb0, qf[0], S1); S0 = MFMA32(ka1, qf[1], S0); S1 = MFMA32(kb1, qf[1], S1); \
            const LAS unsigned char* vbA = lds + AT_V + (buf) * 9216 + qrow * 144 + (8 * hh) * 2; \
            bf16x8 vfa[4], vfb[4]; \
            _Pragma("unroll") for (int i = 0; i < 4; ++i) vfa[i] = *(const LAS bf16x8*)(vbA + (i >> 1) * (32 * 144) + (i & 1) * 32); \
            float pa[16], pb[16]; \
            _Pragma("unroll") for (int i = 0; i < 16; ++i) pa[i] = __builtin_amdgcn_exp2f(S0[i]); \
            _Pragma("unroll") for (int i = 0; i < 8; ++i) lv += (f32x2v){pa[2 * i], pa[2 * i + 1]}; \
            bf16x8 pfa[2], pfb[2]; \
            _Pragma("unroll") for (int s = 0; s < 2; ++s) pfa[s] = pack8(pa[8 * s], pa[8 * s + 1], pa[8 * s + 2], pa[8 * s + 3], pa[8 * s + 4], pa[8 * s + 5], pa[8 * s + 6], pa[8 * s + 7]); \
            _Pragma("unroll") for (int i = 0; i < 4; ++i) o1[i >> 1] = MFMA32(vfa[i], pfa[i & 1], o1[i >> 1]); \
            _Pragma("unroll") for (int i = 0; i < 4; ++i) vfb[i] = *(const LAS bf16x8*)(vbA + 64 + (i >> 1) * (32 * 144) + (i & 1) * 32); \
            _Pragma("unroll") for (int i = 0; i < 16; ++i) pb[i] = __builtin_amdgcn_exp2f(S1[i]); \
            _Pragma("unroll") for (int i = 0; i < 8; ++i) lv += (f32x2v){pb[2 * i], pb[2 * i + 1]}; \
            _Pragma("unroll") for (int s = 0; s < 2; ++s) pfb[s] = pack8(pb[8 * s], pb[8 * s + 1], pb[8 * s + 2], pb[8 * s + 3], pb[8 * s + 4], pb[8 * s + 5], pb[8 * s + 6], pb[8 * s + 7]); \
            _Pragma("unroll") for (int i = 0; i < 4; ++i) o1[i >> 1] = MFMA32(vfb[i], pfb[i & 1], o1[i >> 1]); \
        } else C_TILE_SLOW(buf, kt); } while (0)
    u32x4 Ak, Av, Bk, Bv;
    LOAD_SET(A, 0); LOAD_SET(B, 1);
    STORE_SET(A, 0);
    LOAD_SET(A, 2);
    __syncthreads();
    for (int kt = 0; kt < kt_hi; kt += 2) {
        STORE_SET(B, 1); LOAD_SET(B, kt + 3);
        C_TILE(0, kt);
        __syncthreads();
        STORE_SET(A, 0); LOAD_SET(A, kt + 4);
        C_TILE(1, kt + 1);
        __syncthreads();
    }
#undef LOAD_SET
#undef STORE_SET
#undef C_TILE
#undef C_TILE_SLOW
    l1 += lv.x + lv.y;
    l1 += __shfl_xor(l1, 32);
    LAS float* cb = (LAS float*)lds + (size_t)wq * 33 * 64 + lane;
    if (map == 1) {
#pragma unroll
        for (int d = 0; d < 2; ++d)
#pragma unroll
            for (int i = 0; i < 16; ++i) cb[(d * 16 + i) * 64] = o1[d][i];
        cb[32 * 64] = l1;
    }
    __syncthreads();
    if (map == 0) {
        const float inv1 = 1.0f / l1, c2 = lam / cb[32 * 64]; float ss = 0.f;
#pragma unroll
        for (int d = 0; d < 2; ++d)
#pragma unroll
            for (int i = 0; i < 16; ++i) { const float o = o1[d][i] * inv1 - cb[(d * 16 + i) * 64] * c2; o1[d][i] = o; ss += o * o; }
        ss += __shfl_xor(ss, 32);
        const float r = (1.0f - a.lam_init[layer]) / sqrtf(ss * (1.f / 64.f) + 1e-6f);
        const float* sg = sptr(a.in[I_SUBLN]) + layer * 64 + 4 * hh;
        bf16* yrow = Y + tok * DM + ycol + 4 * hh;
#pragma unroll
        for (int d = 0; d < 2; ++d)
#pragma unroll
            for (int g = 0; g < 4; ++g) { const f32x4 gg = *(const f32x4*)(sg + 32 * d + 8 * g);
                u32x2 w; w.x = pk2(o1[d][4 * g] * r * gg.x, o1[d][4 * g + 1] * r * gg.y); w.y = pk2(o1[d][4 * g + 2] * r * gg.z, o1[d][4 * g + 3] * r * gg.w);
                *(u32x2*)(yrow + 32 * d + 8 * g) = w; }
    }
    __syncthreads();
}
__device__ __forceinline__ void attn_swa(const LAS Args& a, int layer, LAS unsigned char* lds, int b, int kvh, int qt) {
    int tid_ = threadIdx.x; asm volatile("" : "+v"(tid_));
    const int tid = tid_, lane = tid & 63, wave = __builtin_amdgcn_readfirstlane(tid >> 6), qrow = lane & 31, hh = lane >> 5;
    const int q0 = qt * 256, q0w = q0 + wave * 32, qpos = q0w + qrow;
    const size_t tok = (size_t)b * SEQ + qpos;
    const bf16* QKV = (const bf16*)(sptr(a.ws) + WS_QKV); const bf16* VT = (const bf16*)(sptr(a.ws) + WS_VT); bf16* Y = (bf16*)(sptr(a.ws) + WS_H);
    const int kcol = 1280 + kvh * 64, hv = 4 + kvh;
    const int kt_lo = q0 >= 128 ? (q0 - 128) / 64 : 0, nt = 4 * (qt + 1) - kt_lo;
    { const int lrow = tid >> 3, lch = tid & 7;
        const bf16* kg = QKV + ((size_t)b * SEQ + lrow) * NQKV + kcol + 8 * lch;
        const bf16* vg = VT + (((size_t)b * 10 + hv) * 64 + lrow) * SEQ + 8 * lch;
        const int st_off = lrow * 144 + lch * 16;
        u32x4 kr[6], vr[6];
#pragma unroll
        for (int t = 0; t < 6; ++t) { const int kt = kt_lo + (t < nt ? t : nt - 1); kr[t] = *(const u32x4*)(kg + (size_t)(kt * 64) * NQKV); vr[t] = *(const u32x4*)(vg + kt * 64); }
#pragma unroll
        for (int t = 0; t < 6; ++t) { *(LAS u32x4*)(lds + t * 18432 + st_off) = kr[t]; *(LAS u32x4*)(lds + t * 18432 + 9216 + st_off) = vr[t]; } }
    __syncthreads();
#pragma unroll 1
    for (int h = 0; h < 4; ++h) {
        const int head = kvh * 4 + h, qcol = 768 + head * 64, ycol = 256 + head * 64;
        bf16x8 qf[4];
#pragma unroll
        for (int i = 0; i < 4; ++i) qf[i] = *(const bf16x8*)(QKV + tok * NQKV + qcol + 16 * i + 8 * hh);
        const float sinkv = __builtin_amdgcn_exp2f(sptr(a.in[I_SINKS])[layer * 8 + head] * 1.44269504f);
        f32x16 o1[2]; float l1 = 0.f;
#pragma unroll
        for (int d = 0; d < 2; ++d)
#pragma unroll
            for (int i = 0; i < 16; ++i) o1[d][i] = 0.f;
#pragma unroll 1
        for (int t = 0; t < nt; ++t) {
            const LAS unsigned char* stg = lds + t * 18432;
#pragma unroll 1
            for (int sub = 0; sub < 2; ++sub) {
                const int k0s = (kt_lo + t) * 64 + 32 * sub;
                if ((k0s > q0w + 31) || (k0s + 31 + 127 < q0w)) continue;
                const bool needmask = !((k0s + 31 <= q0w) && (k0s + 127 >= q0w + 31));
                f32x16 S1;
#pragma unroll
                for (int i = 0; i < 16; ++i) S1[i] = 0.f;
                const LAS unsigned char* kb = stg + (32 * sub + qrow) * 144 + hh * 16;
#pragma unroll
                for (int i = 0; i < 4; ++i) { const bf16x8 kf = *(const LAS bf16x8*)(kb + i * 32); S1 = MFMA32(kf, qf[i], S1); }
                const int dbase = qpos - k0s - 4 * hh;
                float p1[16];
                if (needmask) {
#pragma unroll
                    for (int i = 0; i < 16; ++i) { const int ci = (i & 3) + 8 * (i >> 2); float e1 = __builtin_amdgcn_exp2f(S1[i]); e1 = (unsigned)(dbase - ci) < 128u ? e1 : 0.f; l1 += e1; p1[i] = e1; }
                } else {
#pragma unroll
                    for (int i = 0; i < 16; ++i) { const float e1 = __builtin_amdgcn_exp2f(S1[i]); l1 += e1; p1[i] = e1; } }
                bf16x8 pf1[2];
#pragma unroll
                for (int s = 0; s < 2; ++s) pf1[s] = pack8(p1[8 * s], p1[8 * s + 1], p1[8 * s + 2], p1[8 * s + 3], p1[8 * s + 4], p1[8 * s + 5], p1[8 * s + 6], p1[8 * s + 7]);
                const LAS unsigned char* vb = stg + 9216 + qrow * 144 + (32 * sub + 8 * hh) * 2;
#pragma unroll
                for (int d = 0; d < 2; ++d)
#pragma unroll
                    for (int s = 0; s < 2; ++s) { const bf16x8 vf = *(const LAS bf16x8*)(vb + d * (32 * 144) + s * 32); o1[d] = MFMA32(vf, pf1[s], o1[d]); }
            }
        }
        l1 += __shfl_xor(l1, 32);
        l1 += sinkv;
        const float inv1 = 1.0f / l1;
        bf16* yrow = Y + tok * DM + ycol + 4 * hh;
#pragma unroll
        for (int d = 0; d < 2; ++d)
#pragma unroll
            for (int g = 0; g < 4; ++g) { u32x2 w; w.x = pk2(o1[d][4 * g] * inv1, o1[d][4 * g + 1] * inv1); w.y = pk2(o1[d][4 * g + 2] * inv1, o1[d][4 * g + 3] * inv1);
                *(u32x2*)(yrow + 32 * d + 8 * g) = w; }
    }
    __syncthreads();
}
__device__ __forceinline__ void phase_attn(const LAS Args& a, int layer, LAS unsigned char* lds, int qoff = 0) {
    unsigned* queue = (unsigned*)(sptr(a.ws) + WS_CTL) + 64 * layer + qoff;
    volatile LAS unsigned* misc = (volatile LAS unsigned*)(lds + AT_MISC);
    for (;;) {
        if (threadIdx.x == 0) misc[0] = atomicAdd(queue, 1u);
        __syncthreads();
        const unsigned u = misc[0];
        __syncthreads();
        if (u >= (unsigned)NUNITS) break;
        if (u < 512u) { const int qt = 63 - (int)(u >> 3), r = u & 7; attn_c128(a, layer, lds, r >> 2, r & 3, qt); }
        else if (u < 768u) { const int v = (int)u - 512, qt = 31 - (v >> 3), r = v & 7; attn_moba(a, layer, lds, r >> 2, r & 3, qt); }
        else { const int v = (int)u - 768, qt = 31 - (v >> 2), r = v & 3; attn_swa(a, layer, lds, r >> 1, r & 1, qt); }
    }
}

__device__ __forceinline__ void unpack8(const u32x4 w, float (&f)[8]) {
    f[0] = pg8::bflo(w.x); f[1] = pg8::bfhi(w.x); f[2] = pg8::bflo(w.y); f[3] = pg8::bfhi(w.y); f[4] = pg8::bflo(w.z); f[5] = pg8::bfhi(w.z); f[6] = pg8::bflo(w.w); f[7] = pg8::bfhi(w.w);
}
__device__ __forceinline__ void phase_conv(const LAS Args& a, int layer) {
    int tid_ = threadIdx.x; asm volatile("" : "+v"(tid_));
    const int tid = tid_;
    if (tid >= FF / 8) return;
    bf16* ACT = (bf16*)(sptr(a.ws) + WS_U); const bf16* HALO = (const bf16*)(sptr(a.ws) + WS_HALO); const bf16* TOP = (const bf16*)(sptr(a.ws) + WS_TOP);
    const int ch0 = tid * 8;
    const float* cw = sptr(a.in[I_CONVW]) + (size_t)layer * 3 * FF2; const float* cb = sptr(a.in[I_CONVB]) + (size_t)layer * FF2;
    float wg[3][8], wv[3][8], bg[8], bv[8];
#pragma unroll
    for (int e = 0; e < 8; ++e) {
#pragma unroll
        for (int j = 0; j < 3; ++j) { wg[j][e] = cw[j * FF2 + ch0 + e]; wv[j][e] = cw[j * FF2 + FF + ch0 + e]; }
        bg[e] = cb[ch0 + e]; bv[e] = cb[FF + ch0 + e]; }
    for (int c = blockIdx.x; c < MTOK / 64; c += gridDim.x) {
        float g2[8], g1[8], v2[8], v1[8];
        if ((c * 64) % SEQ == 0) {
#pragma unroll
            for (int e = 0; e < 8; ++e) { g2[e] = 0.f; g1[e] = 0.f; v2[e] = 0.f; v1[e] = 0.f; }
        } else { const bf16* hp = HALO + (size_t)(c - 1) * 2 * FF2;
            unpack8(*(const u32x4*)(hp + ch0), g2); unpack8(*(const u32x4*)(hp + FF + ch0), v2);
            unpack8(*(const u32x4*)(hp + FF2 + ch0), g1); unpack8(*(const u32x4*)(hp + FF2 + FF + ch0), v1); }
        const bf16* tp = TOP + (size_t)c * 2 * FF2;
#pragma unroll
        for (int r = 0; r < 2; ++r) {
            float g0[8], v0[8], o[8]; unpack8(*(const u32x4*)(tp + (size_t)r * FF2 + ch0), g0); unpack8(*(const u32x4*)(tp + (size_t)r * FF2 + FF + ch0), v0);
#pragma unroll
            for (int e = 0; e < 8; ++e) {
                const float yg = bg[e] + wg[0][e] * g2[e] + wg[1][e] * g1[e] + wg[2][e] * g0[e];
                const float yv = bv[e] + wv[0][e] * v2[e] + wv[1][e] * v1[e] + wv[2][e] * v0[e];
                o[e] = yg * pg8::sigmoidf_(yg) * yv;
                g2[e] = g1[e]; g1[e] = g0[e]; v2[e] = v1[e]; v1[e] = v0[e]; }
            u32x4 w; w.x = pk2(o[0], o[1]); w.y = pk2(o[2], o[3]); w.z = pk2(o[4], o[5]); w.w = pk2(o[6], o[7]);
            *(u32x4*)(ACT + (size_t)(c * 64 + r) * FF + ch0) = w; }
    }
}

#ifndef PHM
#define PHM 0x3ff
#endif
#ifndef REPM
#define REPM 0
#endif
#define IN(k) (lo <= (k) && (k) < hi)
#define XB_TMO      128
#define XB_XCNT(j)  (256  + 64 * (j))
#define XB_XSUB(j)  (1280 + 64 * (j))
#define XB_XGEN(j)  (2304 + 64 * (j))
#define XB_TOP      3328
#define XB_TOPGEN   3392
#define XCD_BAR_WORDS 3456
#define XB_SPIN_CAP (1u << 18)

__device__ __forceinline__ unsigned xb_ld(unsigned* p)              { return __hip_atomic_load(p, __ATOMIC_RELAXED, __HIP_MEMORY_SCOPE_AGENT); }
__device__ __forceinline__ unsigned xb_add(unsigned* p, unsigned v) { return __hip_atomic_fetch_add(p, v, __ATOMIC_RELAXED, __HIP_MEMORY_SCOPE_AGENT); }
__device__ __forceinline__ unsigned xb_xcc_id() { return (unsigned)__builtin_amdgcn_s_getreg((3 << 11) | 20) & 0xFu; }
#define XB_SPIN(cond, bar) do { unsigned _sp = 0; while (cond) { __builtin_amdgcn_s_sleep(1); \
    if ((++_sp & 255u) == 0u) { if (xb_ld(&(bar)[XB_TMO])) break; if (_sp > XB_SPIN_CAP) { atomicAdd(&(bar)[XB_TMO], 1u); break; } } } } while (0)

struct XcdBarrier {
    unsigned* bar; unsigned x;
    volatile LAS unsigned* st;
};

__device__ __forceinline__ XcdBarrier xcd_barrier_post(unsigned* bar, volatile LAS unsigned* st) {
    XcdBarrier b; b.bar = bar; b.x = xb_xcc_id(); b.st = st;
    if (threadIdx.x == 0) (void)xb_add(&bar[XB_XCNT(b.x)], 1u);
    return b;
}
__device__ __forceinline__ void xcd_barrier_complete(unsigned* bar, unsigned x, unsigned& nloc, unsigned& nx) {
    const unsigned G = gridDim.x * gridDim.y * gridDim.z;
    unsigned sum, cnt, mine, sp = 0u;
    for (;;) {
        sum = 0u; cnt = 0u; mine = 0u;
#pragma unroll
        for (unsigned j = 0; j < 16; ++j) { const unsigned c = xb_ld(&bar[XB_XCNT(j)]); sum += c; cnt += (c > 0u) ? 1u : 0u; mine = (j == x) ? c : mine; }
        if (sum == G) break;
        __builtin_amdgcn_s_sleep(1);
        if ((++sp & 255u) == 0u) { if (xb_ld(&bar[XB_TMO])) break; if (sp > XB_SPIN_CAP) { atomicAdd(&bar[XB_TMO], 1u); break; } }
    }
    nloc = mine > 0u ? mine : 1u; nx = cnt > 0u ? cnt : 1u;
}

__device__ __forceinline__ void xcd_barrier(const XcdBarrier& b) {
    asm volatile("s_waitcnt vmcnt(0)" ::: "memory");
    __syncthreads();
    if (threadIdx.x == 0) {
        unsigned* bar = b.bar;
        __builtin_amdgcn_s_waitcnt(0);
        unsigned nloc = b.st[0], nx = b.st[1];
        if (nloc == 0u) { xcd_barrier_complete(bar, b.x, nloc, nx); b.st[0] = nloc; b.st[1] = nx; }
        const unsigned old = xb_add(&bar[XB_XSUB(b.x)], 1u);
        const unsigned gen = old / nloc;
        if (old + 1u == (gen + 1u) * nloc) {
            __builtin_amdgcn_fence(__ATOMIC_RELEASE, "agent");
            asm volatile("s_waitcnt vmcnt(0)" ::: "memory");
            const unsigned og = xb_add(&bar[XB_TOP], 1u);
            const unsigned tg = og / nx;
            if (og + 1u == (tg + 1u) * nx) xb_add(&bar[XB_TOPGEN], 1u);
            else XB_SPIN(xb_ld(&bar[XB_TOPGEN]) == tg, bar);
            __builtin_amdgcn_fence(__ATOMIC_ACQUIRE, "agent");
            xb_add(&bar[XB_XGEN(b.x)], 1u);
            asm volatile("s_waitcnt vmcnt(0)" ::: "memory");
        } else {
            XB_SPIN(xb_ld(&bar[XB_XGEN(b.x)]) == gen, bar);
            __builtin_amdgcn_fence(__ATOMIC_ACQUIRE, "agent");
            asm volatile("s_waitcnt vmcnt(0)" ::: "memory");
        }
    }
    __syncthreads();
}


#ifndef TSEL
#define TSEL -1
#endif
#define SEAM(k) do { if (IN(k) && IN((k) + 1)) xcd_barrier(xbar); if (TSEL >= 0 && threadIdx.x == 0) ((LAS unsigned long long*)(lds + 132096 + 1024))[(k) + 1] = __builtin_amdgcn_s_memrealtime(); } while (0)
template <int L>
__device__ __forceinline__ void layer_prog(const LAS Args& a, LAS unsigned char* lds, const XcdBarrier& xbar, const int lo, const int hi) {
    unsigned char* ws = sptr(a.ws);
    bf16* Wb = (bf16*)(ws + WS_W);
    bf16* H = (bf16*)(ws + WS_H); bf16* G = (bf16*)(ws + WS_G); bf16* QKV = (bf16*)(ws + WS_QKV); bf16* U = (bf16*)(ws + WS_U); bf16* HALO = (bf16*)(ws + WS_HALO);
    const int G_ = gridDim.x, c_ = blockIdx.x;
    constexpr int B0 = 10 * L;
    const float* xin = L == 0 ? sptr(a.in[I_X]) : sptr(a.out);
    if (IN(B0 + 0) && (PHM & 1)) for (int rep = 0; rep < 1 + (REPM & 1); ++rep) { phase_convert(a, L, lds); phase_norm(xin, sptr(a.in[I_ATTN_NORM]) + L * DM, H); }
    SEAM(B0 + 0);
    if (IN(B0 + 1) && (PHM >> 1 & 1)) for (int rep = 0; rep < 1 + (REPM >> 1 & 1); ++rep) { pg8::Gemm g{H, (const bf16*)((char*)Wb + W_IN), MTOK, NIN, DM, DM}; pg8::StaticOrder S; S.init(MTOK, NIN, G_, c_);
        pg8::EpiProj E{QKV, G}; pg8::gemm_phase<pg8::EpiProj, pg8::StaticOrder, true, true>(lds, g, S, E); }
    SEAM(B0 + 1);
    if (IN(B0 + 2) && (PHM >> 2 & 1)) phase_prep(a, L, lds);
    SEAM(B0 + 2);
    if (IN(B0 + 3) && (PHM >> 3 & 1)) { phase_attn(a, L, lds); if (REPM >> 3 & 1) phase_attn(a, L, lds, 32); }
    SEAM(B0 + 3);
    if (IN(B0 + 4) && (PHM >> 4 & 1)) for (int rep = 0; rep < 1 + (REPM >> 4 & 1); ++rep) {
        pg8::StaticOrder S; S.init(MTOK, DM, G_, c_);
        { pg8::Gemm g{H, (const bf16*)((char*)Wb + W_PA), MTOK, DM, 256, DM}; pg8::EpiGate<0> E{G, 0, QKV}; pg8::gemm_phase<pg8::EpiGate<0>, pg8::StaticOrder, true, true>(lds, g, S, E); }
        { pg8::Gemm g{H + 256, (const bf16*)((char*)Wb + W_PB), MTOK, DM, 512, DM}; pg8::EpiGate<1> E{G, 1024, QKV}; pg8::gemm_phase<pg8::EpiGate<1>, pg8::StaticOrder, true, true>(lds, g, S, E); }
        { pg8::Gemm g{H + 768, (const bf16*)((char*)Wb + W_PC), MTOK, DM, 256, DM}; pg8::EpiGate<1> E{G, 2048, QKV}; pg8::gemm_phase<pg8::EpiGate<1>, pg8::StaticOrder, true, true>(lds, g, S, E); }
    }
    SEAM(B0 + 4);
    if (IN(B0 + 5) && (PHM >> 5 & 1)) { pg8::Gemm g{QKV, (const bf16*)((char*)Wb + W_OUT), MTOK, DM, DM, DM}; pg8::StaticOrder S; S.init(MTOK, DM, G_, c_);
        pg8::EpiResid E{xin, sptr(a.out)}; pg8::gemm_phase<pg8::EpiResid, pg8::StaticOrder, true, true>(lds, g, S, E); }
    SEAM(B0 + 5);
    if (IN(B0 + 6) && (PHM >> 6 & 1)) for (int rep = 0; rep < 1 + (REPM >> 6 & 1); ++rep) phase_norm(sptr(a.out), sptr(a.in[I_MLP_NORM]) + L * DM, H);
    SEAM(B0 + 6);
    if (IN(B0 + 7) && (PHM >> 7 & 1)) for (int rep = 0; rep < 1 + (REPM >> 7 & 1); ++rep) { pg8::Gemm g{H, (const bf16*)((char*)Wb + W_UP), MTOK, FF2, DM, DM}; pg8::StaticOrder S; S.init(MTOK, FF2, G_, c_);
        pg8::EpiUpConv E{U, HALO, (bf16*)(ws + WS_TOP), sptr(a.in[I_CONVW]) + (size_t)L * 3 * FF2, sptr(a.in[I_CONVB]) + (size_t)L * FF2};
        pg8::gemm_phase<pg8::EpiUpConv, pg8::StaticOrder, true, true>(lds, g, S, E); }
    SEAM(B0 + 7);
    if (IN(B0 + 8) && (PHM >> 8 & 1)) phase_conv(a, L);
    SEAM(B0 + 8);
    if (IN(B0 + 9) && (PHM >> 9 & 1)) { pg8::Gemm g{U, (const bf16*)((char*)Wb + W_DOWN), MTOK, DM, FF, FF}; pg8::StaticOrder S; S.init(MTOK, DM, G_, c_);
        pg8::EpiResid E{sptr(a.out), sptr(a.out)}; pg8::gemm_phase<pg8::EpiResid, pg8::StaticOrder, true, true>(lds, g, S, E); }
    SEAM(B0 + 9);
}
__global__ void __launch_bounds__(512, 2) mega_fwd(Args a) {
    extern __shared__ __attribute__((aligned(16))) unsigned char lds_raw[];
    LAS unsigned char* lds = (LAS unsigned char*)lds_raw;
    const int lo = a.ph_lo, hi = a.ph_hi;
    LAS Args& la = *(LAS Args*)(lds + 132096);
    if (threadIdx.x == 0) {
#pragma unroll
        for (int i = 0; i < 24; ++i) la.in[i] = a.in[i];
        la.out = a.out; la.ws = a.ws;
#pragma unroll
        for (int i = 0; i < 32; ++i) la.inv64[i] = a.inv64[i];
#pragma unroll
        for (int i = 0; i < 16; ++i) la.inv32[i] = a.inv32[i];
        la.lam_init[0] = a.lam_init[0]; la.lam_init[1] = a.lam_init[1]; la.ph_lo = lo; la.ph_hi = hi;
        ((LAS unsigned*)(lds + 132096 + 512))[0] = 0u; ((LAS unsigned*)(lds + 132096 + 512))[1] = 0u;
    }
    __syncthreads();
    if (hi - lo > 1) cg::this_grid().sync();
    XcdBarrier xbar; xbar.bar = (unsigned*)(a.ws + WS_CTL) + 1024; xbar.x = 0; xbar.st = nullptr;
    if (hi - lo > 1) xbar = xcd_barrier_post((unsigned*)(a.ws + WS_CTL) + 1024, (volatile LAS unsigned*)(lds + 132096 + 512));
    if (TSEL >= 0 && threadIdx.x == 0) ((LAS unsigned long long*)(lds + 132096 + 1024))[0] = __builtin_amdgcn_s_memrealtime();
    layer_prog<0>(la, lds, xbar, lo, hi);
    layer_prog<1>(la, lds, xbar, lo, hi);
    if (TSEL >= 0) { xcd_barrier(xbar); if (blockIdx.x == 0 && threadIdx.x == 0) { LAS unsigned long long* ts = (LAS unsigned long long*)(lds + 132096 + 1024);
        a.out[0] += floorf((float)(ts[TSEL + 1] - ts[TSEL]) * 0.01f * (1.f / 16.f)) * 16.f + 8.f; } }
}

#ifndef MK_MULTI
#define MK_MULTI 0
#endif
extern "C" void kernel_launch(void* const* d_in, const int* in_sizes, int n_in, void* d_out, int out_size, void* d_ws, size_t ws_size, hipStream_t stream) {
    static int grid = 0;
    if (grid == 0) {
        if (n_in != 24 || ws_size < WS_END) { fprintf(stderr, "kernel_launch: unexpected n_in %d / ws %zu\n", n_in, ws_size); grid = -1; return; }
        int dev = 0, cus = 0, per_cu = 0;
        (void)hipGetDevice(&dev); (void)hipDeviceGetAttribute(&cus, hipDeviceAttributeMultiprocessorCount, dev);
        if (hipFuncSetAttribute((const void*)mega_fwd, hipFuncAttributeMaxDynamicSharedMemorySize, LDS_BYTES) != hipSuccess) { fprintf(stderr, "hipFuncSetAttribute failed\n"); grid = -1; return; }
        if (hipOccupancyMaxActiveBlocksPerMultiprocessor(&per_cu, (const void*)mega_fwd, 512, LDS_BYTES) != hipSuccess || per_cu < 1) per_cu = 1;
        (void)hipGetLastError();
        grid = cus * per_cu;
        fprintf(stderr, "kernel_launch: cus %d per_cu %d grid %d\n", cus, per_cu, grid);
    }
    if (grid < 0) return;
    (void)hipMemsetAsync((char*)d_ws + WS_CTL, 0, 32768, stream);
    Args a{};
    for (int i = 0; i < 24; ++i) a.in[i] = (const float*)d_in[i];
    a.out = (float*)d_out; a.ws = (unsigned char*)d_ws;
    for (int i = 0; i < 32; ++i) a.inv64[i] = 1.0f / powf(10000.0f, (float)(2 * i) / 64.0f);
    for (int i = 0; i < 16; ++i) a.inv32[i] = 1.0f / powf(10000.0f, (float)(2 * i) / 32.0f);
    for (int i = 0; i < 2; ++i) a.lam_init[i] = (float)(0.8 - 0.6 * exp(-0.3 * (double)i));
#if MK_MULTI
    for (int ph = 0; ph < NPH; ++ph) { a.ph_lo = ph; a.ph_hi = ph + 1; hipLaunchKernelGGL(mega_fwd, dim3(grid), dim3(512), LDS_BYTES, stream, a); }
#else
    a.ph_lo = 0; a.ph_hi = NPH;
    void* args[] = {&a};
    hipError_t e = hipLaunchCooperativeKernel((const void*)mega_fwd, dim3(grid), dim3(512), args, LDS_BYTES, stream);
    if (e != hipSuccess) fprintf(stderr, "cooperative launch failed: %s (grid %d)\n", hipGetErrorString(e), grid);
#endif
}
```
